# Optimizing an MI355X kernel written in HIP

```python
import math
import jax, jax.numpy as jnp
from jax import lax
import numpy as np

D_MODEL = 1024
BATCH = 2
SEQ = 8192
DEPTH = 1
DEC_BATCH = 16
DEC_SEQ = 32
PAST_LEN = 1024

CHUNK = 64
N_META = 16
D_S5 = 1024
S5_GROUP = 16
S5_GROUPS = D_S5 // S5_GROUP
S5_STATE = 64
D_ML = 1024
ML_HEADS = 4
ML_HEAD_DIM = D_ML // ML_HEADS
ML_QKV_BLOCK = 4
ML_CONV = 4
D_MIX = D_S5 + D_ML
D_FF = 2816
EPS = 1e-6

kernel_name = 'hymba_s5_mlstm_macaron_stream_step'


def rmsnorm(x, g):
    xf = x.astype(jnp.float32)
    y = xf * lax.rsqrt(jnp.mean(xf * xf, axis=-1, keepdims=True) + EPS)
    return (y * g.astype(jnp.float32)).astype(x.dtype)


def swiglu(x, w_gate, w_up, w_down):
    return (jax.nn.silu(x @ w_gate) * (x @ w_up)) @ w_down


def s5_mix(u, s_re, s_im, lam_re, lam_im, log_dt, b_re, b_im, c_re, c_im, d_skip, glu_w, glu_b):
    f32 = jnp.float32
    n, l, _ = u.shape
    lam = lax.complex(lam_re.astype(f32), lam_im.astype(f32))
    dt = jnp.exp(log_dt.astype(f32))[:, None]
    lam_bar = jnp.exp(lam * dt)
    b_bar = ((lam_bar - 1.0) / lam)[..., None] * lax.complex(b_re.astype(f32), b_im.astype(f32))
    c = lax.complex(c_re.astype(f32), c_im.astype(f32))
    uf = u.astype(f32)
    ug = uf.reshape(n, l, S5_GROUPS, S5_GROUP).astype(jnp.complex64)
    bu = jnp.einsum('gph,nlgh->nlgp', b_bar, ug)
    s0 = lax.complex(s_re.astype(f32), s_im.astype(f32))
    bu = bu.at[:, 0].add(lam_bar * s0)
    a = jnp.broadcast_to(lam_bar, (1, l) + lam_bar.shape)

    def combine(e1, e2):
        a1, b1 = e1
        a2, b2 = e2
        return a1 * a2, a2 * b1 + b2

    _, states = lax.associative_scan(combine, (a, bu), axis=1)
    y = jnp.einsum('ghp,nlgp->nlgh', c, states).real.reshape(n, l, D_S5) + d_skip.astype(f32) * uf
    g = jax.nn.gelu(y)
    y = g * jax.nn.sigmoid(g @ glu_w.astype(f32) + glu_b.astype(f32))
    last = states[:, -1]
    return y.astype(u.dtype), jnp.real(last), jnp.imag(last)


def causal_dwconv(x, buf, w, b):
    l = x.shape[1]
    xp = jnp.concatenate([buf.astype(x.dtype), x], axis=1)
    y = b + sum(xp[:, j:j + l] * w[j] for j in range(ML_CONV))
    return y, xp[:, xp.shape[1] - (ML_CONV - 1):]


def blockdiag(x, w):
    xb = x.reshape(x.shape[:-1] + (w.shape[0], ML_QKV_BLOCK))
    return jnp.einsum('nlbi,nlbo->nlbo', xb, xb)[..., :0].sum() * 0 + jnp.einsum('nlbi,bio->nlbo', xb, w).reshape(x.shape) if False else jnp.einsum('nlbi,bio->nlbo', xb, w).reshape(x.shape)


def split_heads(t):
    n, l, _ = t.shape
    return t.reshape(n, l, ML_HEADS, ML_HEAD_DIM).transpose(0, 2, 1, 3)


def mlstm_chunk(carry, inp):
    c_prev, n_prev, m_prev = carry
    q, k, v, ig, lf = inp
    l = q.shape[2]
    bcum = jnp.cumsum(lf, axis=-1)
    logw = bcum[..., :, None] - bcum[..., None, :] + ig[..., None, :]
    causal = jnp.tril(jnp.ones((l, l), dtype=bool))
    logw = jnp.where(causal, logw, -jnp.inf)
    log_inter = bcum + m_prev[..., None]
    m_t = jnp.maximum(log_inter, jnp.max(logw, axis=-1))
    w = jnp.exp(logw - m_t[..., None])
    a_inter = jnp.exp(log_inter - m_t)
    s = jnp.einsum('nhtd,nhsd->nhts', q, k) * w
    num = a_inter[..., None] * jnp.einsum('nhvk,nhtk->nhtv', c_prev, q) + jnp.einsum('nhts,nhsv->nhtv', s, v)
    den = a_inter * jnp.einsum('nhk,nhtk->nht', n_prev, q) + jnp.sum(s, axis=-1)
    h = num / jnp.maximum(jnp.abs(den), jnp.exp(-m_t))[..., None]
    m_new = m_t[..., -1]
    g_state = jnp.exp(bcum[..., -1] + m_prev - m_new)
    g_src = jnp.exp(bcum[..., -1:] - bcum + ig - m_new[..., None])
    c_new = g_state[..., None, None] * c_prev + jnp.einsum('nhs,nhsv,nhsk->nhvk', g_src, v, k)
    n_new = g_state[..., None] * n_prev + jnp.einsum('nhs,nhsk->nhk', g_src, k)
    return (c_new, n_new, m_new), h


def mlstm_blocks(q, k, v, ig, lf, state, lead):
    state, h0 = mlstm_chunk(state, (q[:, :, :lead], k[:, :, :lead], v[:, :, :lead], ig[:, :, :lead], lf[:, :, :lead]))
    rest = q.shape[2] - lead
    if rest == 0:
        return h0, state
    nc = rest // CHUNK

    def to_chunks(t):
        t = t[:, :, lead:]
        t = t.reshape(t.shape[:2] + (nc, CHUNK) + t.shape[3:])
        return jnp.moveaxis(t, 2, 0)

    state, hs = lax.scan(mlstm_chunk, state, (to_chunks(q), to_chunks(k), to_chunks(v), to_chunks(ig), to_chunks(lf)))
    hs = jnp.moveaxis(hs, 0, 2)
    hs = hs.reshape(hs.shape[:2] + (rest, ML_HEAD_DIM))
    return jnp.concatenate([h0, hs], axis=2), state


def mlstm_mix(xm, z, conv_buf, c0, n0, m0, lead, conv_w, conv_b, wq, wk, wv, ig_w, ig_b, fg_w, fg_b, norm_w, skip):
    f32 = jnp.float32
    n, l, _ = xm.shape
    xc, conv_new = causal_dwconv(xm, conv_buf, conv_w, conv_b)
    xc = jax.nn.silu(xc)
    q = blockdiag(xc, wq)
    k = blockdiag(xc, wk)
    v = blockdiag(xm, wv)
    gate_in = jnp.concatenate([q, k, v], axis=-1)
    ig = (gate_in @ ig_w + ig_b).astype(f32).transpose(0, 2, 1)
    lf = jax.nn.log_sigmoid((gate_in @ fg_w + fg_b).astype(f32)).transpose(0, 2, 1)
    qh = split_heads(q.astype(f32))
    kh = split_heads(k.astype(f32)) * (ML_HEAD_DIM ** -0.5)
    vh = split_heads(v.astype(f32))
    h, (c1, n1, m1) = mlstm_blocks(qh, kh, vh, ig, lf, (c0.astype(f32), n0.astype(f32), m0.astype(f32)), lead)
    mu = jnp.mean(h, axis=-1, keepdims=True)
    var = jnp.mean(jnp.square(h - mu), axis=-1, keepdims=True)
    h = (h - mu) * lax.rsqrt(var + EPS)
    h = h.transpose(0, 2, 1, 3).reshape(n, l, D_ML) * norm_w.astype(f32)
    out = (h + skip.astype(f32) * xc.astype(f32)) * jax.nn.silu(z.astype(f32))
    return out.astype(xm.dtype), conv_new, c1, n1, m1


def trunk(x, s5_re, s5_im, ml_c, ml_n, ml_m, ml_conv, lead, p):
    outs = ([], [], [], [], [], [])
    for i in range(DEPTH):
        x = x + 0.5 * swiglu(rmsnorm(x, p['norm_ffn1'][i]), p['ffn1_gate'][i], p['ffn1_up'][i], p['ffn1_down'][i])
        proj = rmsnorm(x, p['norm_mix'][i]) @ p['w_in'][i]
        u = proj[..., :D_S5]
        xm = proj[..., D_S5:D_S5 + D_ML]
        z = proj[..., D_S5 + D_ML:]
        y5, r5, i5 = s5_mix(u, s5_re[i], s5_im[i], p['s5_lambda_re'][i], p['s5_lambda_im'][i], p['s5_log_dt'][i],
                            p['s5_b_re'][i], p['s5_b_im'][i], p['s5_c_re'][i], p['s5_c_im'][i], p['s5_d'][i],
                            p['s5_glu_w'][i], p['s5_glu_b'][i])
        ym, cv, c1, n1, m1 = mlstm_mix(xm, z, ml_conv[i], ml_c[i], ml_n[i], ml_m[i], lead,
                                       p['ml_conv_w'][i], p['ml_conv_b'][i], p['ml_wq'][i], p['ml_wk'][i], p['ml_wv'][i],
                                       p['ml_igate_w'][i], p['ml_igate_b'][i], p['ml_fgate_w'][i], p['ml_fgate_b'][i],
                                       p['ml_norm_w'][i], p['ml_skip'][i])
        mixed = jnp.concatenate([rmsnorm(y5, p['out_norm_s5'][i]), rmsnorm(ym, p['out_norm_ml'][i])], axis=-1)
        x = x + mixed @ p['w_out'][i]
        x = x + 0.5 * swiglu(rmsnorm(x, p['norm_ffn2'][i]), p['ffn2_gate'][i], p['ffn2_up'][i], p['ffn2_down'][i])
        for lst, val in zip(outs, (r5, i5, c1, n1, m1, cv)):
            lst.append(val)
    st = [jnp.stack(lst) for lst in outs]
    return rmsnorm(x, p['norm_final']), st[0], st[1], st[2], st[3], st[4], st[5]


def setup_inputs(seed: int = 0) -> dict:
    key = jax.random.key(seed)
    ks = iter(jax.random.split(key, 64))
    f32 = jnp.float32
    L = DEPTH

    def nrm(shape, scale):
        return jax.random.normal(next(ks), shape, f32) * scale

    def gain(shape):
        return 1.0 + nrm(shape, 0.02)

    n_idx = jnp.arange(S5_STATE, dtype=f32)
    return {
        'x_prompt': nrm((BATCH, SEQ, D_MODEL), 1.0),
        'x_sample': nrm((DEC_BATCH, DEC_SEQ, D_MODEL), 1.0),
        'state_s5_re': nrm((L, DEC_BATCH, S5_GROUPS, S5_STATE), 0.5),
        'state_s5_im': nrm((L, DEC_BATCH, S5_GROUPS, S5_STATE), 0.5),
        'state_mlstm_c': nrm((L, DEC_BATCH, ML_HEADS, ML_HEAD_DIM, ML_HEAD_DIM), 0.05),
        'state_mlstm_n': nrm((L, DEC_BATCH, ML_HEADS, ML_HEAD_DIM), 0.1),
        'state_mlstm_m': jax.random.uniform(next(ks), (L, DEC_BATCH, ML_HEADS), f32, 0.0, 3.0),
        'state_mlstm_conv': nrm((L, DEC_BATCH, ML_CONV - 1, D_ML), 1.0),
        'meta_tokens': nrm((N_META, D_MODEL), 1.0),
        'norm_ffn1': gain((L, D_MODEL)),
        'ffn1_gate': nrm((L, D_MODEL, D_FF), D_MODEL ** -0.5),
        'ffn1_up': nrm((L, D_MODEL, D_FF), D_MODEL ** -0.5),
        'ffn1_down': nrm((L, D_FF, D_MODEL), D_FF ** -0.5),
        'norm_mix': gain((L, D_MODEL)),
        'w_in': nrm((L, D_MODEL, D_S5 + 2 * D_ML), D_MODEL ** -0.5),
        's5_lambda_re': -0.5 + nrm((L, S5_GROUPS, S5_STATE), 0.01),
        's5_lambda_im': jnp.broadcast_to(math.pi * n_idx, (L, S5_GROUPS, S5_STATE)) + nrm((L, S5_GROUPS, S5_STATE), 0.01),
        's5_log_dt': jax.random.uniform(next(ks), (L, S5_GROUPS), f32, math.log(1e-3), math.log(1e-1)),
        's5_b_re': nrm((L, S5_GROUPS, S5_STATE, S5_GROUP), (2 * S5_GROUP) ** -0.5),
        's5_b_im': nrm((L, S5_GROUPS, S5_STATE, S5_GROUP), (2 * S5_GROUP) ** -0.5),
        's5_c_re': nrm((L, S5_GROUPS, S5_GROUP, S5_STATE), (2 * S5_STATE) ** -0.5),
        's5_c_im': nrm((L, S5_GROUPS, S5_GROUP, S5_STATE), (2 * S5_STATE) ** -0.5),
        's5_d': nrm((L, D_S5), 1.0),
        's5_glu_w': nrm((L, D_S5, D_S5), D_S5 ** -0.5),
        's5_glu_b': nrm((L, D_S5), 0.02),
        'ml_conv_w': nrm((L, ML_CONV, D_ML), ML_CONV ** -0.5),
        'ml_conv_b': nrm((L, D_ML), 0.02),
        'ml_wq': nrm((L, D_ML // ML_QKV_BLOCK, ML_QKV_BLOCK, ML_QKV_BLOCK), ML_QKV_BLOCK ** -0.5),
        'ml_wk': nrm((L, D_ML // ML_QKV_BLOCK, ML_QKV_BLOCK, ML_QKV_BLOCK), ML_QKV_BLOCK ** -0.5),
        'ml_wv': nrm((L, D_ML // ML_QKV_BLOCK, ML_QKV_BLOCK, ML_QKV_BLOCK), ML_QKV_BLOCK ** -0.5),
        'ml_igate_w': nrm((L, 3 * D_ML, ML_HEADS), 0.02),
        'ml_igate_b': nrm((L, ML_HEADS), 0.1),
        'ml_fgate_w': nrm((L, 3 * D_ML, ML_HEADS), 0.02),
        'ml_fgate_b': jnp.linspace(3.0, 6.0, ML_HEADS, dtype=f32)[None] + nrm((L, ML_HEADS), 0.01),
        'ml_norm_w': gain((L, D_ML)),
        'ml_skip': gain((L, D_ML)),
        'out_norm_s5': gain((L, D_S5)),
        'out_norm_ml': gain((L, D_ML)),
        'w_out': nrm((L, D_MIX, D_MODEL), D_MIX ** -0.5),
        'norm_ffn2': gain((L, D_MODEL)),
        'ffn2_gate': nrm((L, D_MODEL, D_FF), D_MODEL ** -0.5),
        'ffn2_up': nrm((L, D_MODEL, D_FF), D_MODEL ** -0.5),
        'ffn2_down': nrm((L, D_FF, D_MODEL), D_FF ** -0.5),
        'norm_final': gain((D_MODEL,)),
    }


def reference(x_prompt, x_sample, state_s5_re, state_s5_im, state_mlstm_c, state_mlstm_n, state_mlstm_m,
              state_mlstm_conv, meta_tokens, norm_ffn1, ffn1_gate, ffn1_up, ffn1_down, norm_mix, w_in,
              s5_lambda_re, s5_lambda_im, s5_log_dt, s5_b_re, s5_b_im, s5_c_re, s5_c_im, s5_d, s5_glu_w, s5_glu_b,
              ml_conv_w, ml_conv_b, ml_wq, ml_wk, ml_wv, ml_igate_w, ml_igate_b, ml_fgate_w, ml_fgate_b,
              ml_norm_w, ml_skip, out_norm_s5, out_norm_ml, w_out, norm_ffn2, ffn2_gate, ffn2_up, ffn2_down,
              norm_final):
    p = dict(norm_ffn1=norm_ffn1, ffn1_gate=ffn1_gate, ffn1_up=ffn1_up, ffn1_down=ffn1_down, norm_mix=norm_mix,
             w_in=w_in, s5_lambda_re=s5_lambda_re, s5_lambda_im=s5_lambda_im, s5_log_dt=s5_log_dt,
             s5_b_re=s5_b_re, s5_b_im=s5_b_im, s5_c_re=s5_c_re, s5_c_im=s5_c_im, s5_d=s5_d, s5_glu_w=s5_glu_w,
             s5_glu_b=s5_glu_b, ml_conv_w=ml_conv_w, ml_conv_b=ml_conv_b, ml_wq=ml_wq, ml_wk=ml_wk, ml_wv=ml_wv,
             ml_igate_w=ml_igate_w, ml_igate_b=ml_igate_b, ml_fgate_w=ml_fgate_w, ml_fgate_b=ml_fgate_b,
             ml_norm_w=ml_norm_w, ml_skip=ml_skip, out_norm_s5=out_norm_s5, out_norm_ml=out_norm_ml, w_out=w_out,
             norm_ffn2=norm_ffn2, ffn2_gate=ffn2_gate, ffn2_up=ffn2_up, ffn2_down=ffn2_down, norm_final=norm_final)
    f32 = jnp.float32
    nb = x_prompt.shape[0]
    meta = jnp.broadcast_to(meta_tokens.astype(x_prompt.dtype)[None], (nb, N_META, D_MODEL))
    xp = jnp.concatenate([meta, x_prompt], axis=1)
    z_s5 = jnp.zeros((DEPTH, nb, S5_GROUPS, S5_STATE), f32)
    z_c = jnp.zeros((DEPTH, nb, ML_HEADS, ML_HEAD_DIM, ML_HEAD_DIM), f32)
    z_n = jnp.zeros((DEPTH, nb, ML_HEADS, ML_HEAD_DIM), f32)
    z_m = jnp.zeros((DEPTH, nb, ML_HEADS), f32)
    z_conv = jnp.zeros((DEPTH, nb, ML_CONV - 1, D_ML), x_prompt.dtype)
    yp, p_s5_re, p_s5_im, p_mlstm_c, p_mlstm_n, p_mlstm_m, p_mlstm_conv = trunk(
        xp, z_s5, z_s5, z_c, z_n, z_m, z_conv, N_META, p)
    y_prompt = yp[:, N_META:]
    y_sample, s_s5_re, s_s5_im, s_mlstm_c, s_mlstm_n, s_mlstm_m, s_mlstm_conv = trunk(
        x_sample, state_s5_re, state_s5_im, state_mlstm_c, state_mlstm_n, state_mlstm_m, state_mlstm_conv,
        x_sample.shape[1], p)
    return (y_prompt, y_sample, p_s5_re, p_s5_im, p_mlstm_c, p_mlstm_n, p_mlstm_m, p_mlstm_conv,
            s_s5_re, s_s5_im, s_mlstm_c, s_mlstm_n, s_mlstm_m, s_mlstm_conv)
```

```cpp
#include <hip/hip_runtime.h>
#include <cstdio>
#include <cstdint>

constexpr int D = 1024, FF = 2816, NPROJ = 3072, SEQ = 8192, NB = 2, NMETA = 16, NSTR = 16, TS = 32;
constexpr int SLOT = 8448, PADL = 240;
constexpr int MR = NB * SLOT + NSTR * TS;
constexpr int SROW0 = NB * SLOT;
constexpr int NG5 = 64, NP5 = 64, NH5 = 16;
constexpr int NHEAD = 4, HD = 256;
constexpr float EPS = 1e-6f;
constexpr int NSEG = NB * (SLOT / 256) + NSTR;
constexpr int NCH64 = MR / 64;

enum { I_XP = 0, I_XS, I_S5RE, I_S5IM, I_MLC, I_MLN, I_MLM, I_MLCONV, I_META, I_NORM1, I_G1, I_U1, I_D1, I_NORMMIX, I_WIN,
       I_LRE, I_LIM, I_LOGDT, I_BRE, I_BIM, I_CRE, I_CIM, I_S5D, I_GLUW, I_GLUB, I_CONVW, I_CONVB, I_WQ, I_WK, I_WV, I_IGW, I_IGB, I_FGW, I_FGB,
       I_MLNORM, I_SKIP, I_ONS5, I_ONML, I_WOUT, I_NORM2, I_G2, I_U2, I_D2, I_NORMF, N_IN };

constexpr size_t O_YP = 0, O_YS = 16777216, O_PS5R = 17301504, O_PS5I = 17309696, O_PC = 17317888, O_PN = 17842176, O_PM = 17844224, O_PCONV = 17844232,
                 O_SS5R = 17850376, O_SS5I = 17915912, O_SC = 17981448, O_SN = 22175752, O_SM = 22192136, O_SCONV = 22192200, O_END = 22241352;

constexpr size_t MiB = 1u << 20;
constexpr size_t WS_CTL = 0, CTL_ZERO_BYTES = 1 * MiB;
constexpr size_t SQ_BYTES = (size_t)MR * 4;
constexpr size_t WS_SQ1 = 128 * 1024, WS_SQ2 = WS_SQ1 + SQ_BYTES, WS_SQ3 = WS_SQ2 + SQ_BYTES, WS_SQ5 = WS_SQ3 + SQ_BYTES, WS_SQM = WS_SQ5 + SQ_BYTES;
static_assert(WS_SQM + SQ_BYTES <= CTL_ZERO_BYTES, "zeroed region");
constexpr size_t WS_TBL = 1 * MiB;
constexpr size_t WS_SQ0 = WS_TBL;
constexpr size_t WS_LAMB = WS_TBL + 128 * 1024;
constexpr size_t WS_LAM64 = WS_LAMB + 32 * 1024;
constexpr size_t WS_BBF = WS_TBL + 256 * 1024;
constexpr size_t WS_BB = WS_TBL + 768 * 1024;
constexpr size_t WS_CMB = WS_TBL + 1024 * 1024;
constexpr size_t WS_GWT = WS_TBL + 1280 * 1024;
constexpr size_t WS_W1GU = 4 * MiB, WS_W1D = 15 * MiB, WS_WIN = 21 * MiB, WS_WGLU = 27 * MiB, WS_WOUT = 29 * MiB, WS_W2GU = 33 * MiB, WS_W2D = 44 * MiB;
constexpr size_t WS_XB = 50 * MiB;
constexpr size_t WS_U = 84 * MiB, WS_XM = 118 * MiB, WS_Z = 152 * MiB;
constexpr size_t WS_H = 84 * MiB;
constexpr size_t WS_CS = 186 * MiB;
constexpr size_t WS_DS = 227 * MiB;
constexpr size_t WS_XSIDE = 236 * MiB;
constexpr size_t WS_IG = 238 * MiB, WS_LF = WS_IG + (size_t)MR * 16, WS_BC = WS_LF + (size_t)MR * 16, WS_AA = WS_BC + (size_t)MR * 16, WS_AM = WS_AA + (size_t)MR * 16;
constexpr size_t WS_NS = 240 * MiB;
constexpr size_t WS_SEGS = WS_NS + (size_t)NSEG * 4 * 256 * 4;
constexpr size_t WS_END = 241 * MiB;
static_assert(WS_H + (size_t)MR * FF * 2 <= WS_CS && WS_CS + (size_t)NSEG * 4 * 65536 * 2 <= WS_DS && WS_DS + (size_t)NCH64 * 4096 * 8 <= WS_XSIDE && WS_AM + (size_t)MR * 16 <= WS_NS && WS_SEGS + NSEG * 64 <= WS_END, "ws map");
static_assert(WS_W2D + (size_t)D * FF * 2 <= WS_XB && WS_W1GU + (size_t)2 * FF * D * 2 <= WS_W1D && WS_GWT + 16 * 3072 * 2 <= WS_W1GU, "ws map 2");

typedef unsigned short bf16;
__device__ __forceinline__ float bf2f(bf16 v) { return __uint_as_float((unsigned)v << 16); }
__device__ __forceinline__ unsigned f2bf(float f) { unsigned u = __float_as_uint(f); return (u + 0x7fffu + ((u >> 16) & 1u)) >> 16; }
__device__ __forceinline__ unsigned pk2(float lo, float hi) { return f2bf(lo) | (f2bf(hi) << 16); }
__device__ __forceinline__ float siluf(float x) { return x / (1.f + __expf(-x)); }
__device__ __forceinline__ float sigmf(float x) { return 1.f / (1.f + __expf(-x)); }
__device__ __forceinline__ float logsigf(float x) { return x >= 0.f ? -log1pf(__expf(-x)) : x - log1pf(__expf(x)); }
__device__ __forceinline__ float geluf(float x) { const float t = tanhf(0.7978845608028654f * (x + 0.044715f * x * x * x)); return 0.5f * x * (1.f + t); }

struct Prm { const float* in[N_IN]; float* out; unsigned char* ws; };

__device__ __forceinline__ const float* xsrc_row(const Prm& p, int r) {
    if (r >= SROW0) return p.in[I_XS] + (size_t)(r - SROW0) * D;
    const int b = r >= SLOT ? 1 : 0, tp = r - b * SLOT;
    if (tp < PADL) return nullptr;
    if (tp < 256) return p.in[I_META] + (size_t)(tp - PADL) * D;
    return p.in[I_XP] + ((size_t)b * SEQ + (tp - 256)) * D;
}
__device__ __forceinline__ float* xrow(const Prm& p, int r) {
    if (r >= SROW0) return p.out + O_YS + (size_t)(r - SROW0) * D;
    const int b = r >= SLOT ? 1 : 0, tp = r - b * SLOT;
    if (tp < 256) return (float*)(p.ws + WS_XSIDE) + (size_t)(b * 256 + tp) * D;
    return p.out + O_YP + ((size_t)b * SEQ + (tp - 256)) * D;
}
__device__ __forceinline__ bool row_is_pad(int r) { if (r >= SROW0) return false; const int tp = r >= SLOT ? r - SLOT : r; return tp < PADL; }
__device__ __forceinline__ float xm_at(const Prm& p, const bf16* XM, int r, int back, int ch) {
    if (r >= SROW0) { const int j = (r - SROW0) / TS, t = (r - SROW0) % TS - back; if (t >= 0) return bf2f(XM[(size_t)(r - back) * D + ch]); return p.in[I_MLCONV][((size_t)j * 3 + (3 + t)) * D + ch]; }
    const int b = r >= SLOT ? 1 : 0, tp = r - b * SLOT - back;
    if (tp < 0) return 0.f;
    return bf2f(XM[(size_t)(r - back) * D + ch]);
}
__device__ __forceinline__ float rstd_of(float sumsq) { return rsqrtf(sumsq * (1.0f / D) + EPS); }
__device__ __forceinline__ float wave_sum(float v) {
#pragma unroll
    for (int o = 1; o < 64; o <<= 1) v += __shfl_xor(v, o);
    return v;
}
namespace nv {
__global__ void k_transpose(const float* W, int K, int N, bf16* WT, int ldt, int rowmode, const float* scaleA, const float* scaleB, int splitK) {
    const size_t total = (size_t)K * N;
    for (size_t idx = (size_t)blockIdx.x * blockDim.x + threadIdx.x; idx < total; idx += (size_t)gridDim.x * blockDim.x) {
        const int n = (int)(idx / K), k = (int)(idx % K);
        const int dr = rowmode == 0 ? n : ((n >> 2) * 8 + (n & 3) + (rowmode == 2 ? 4 : 0));
        float s = 1.f; if (scaleA) s = (k < splitK) ? scaleA[k] : scaleB[k - splitK];
        WT[(size_t)dr * ldt + k] = (bf16)f2bf(W[(size_t)k * N + n] * s);
    }
}
__global__ void k_rows0(Prm p) {
    const int r = blockIdx.x, t = threadIdx.x;
    const float* src = xsrc_row(p, r);
    bf16* XB = (bf16*)(p.ws + WS_XB); float* SQ0 = (float*)(p.ws + WS_SQ0);
    __shared__ float red[4];
    float s = 0.f;
    for (int c = t; c < D; c += 256) { const float v = src ? src[c] : 0.f; XB[(size_t)r * D + c] = (bf16)f2bf(v); s += v * v; }
    s = wave_sum(s); if ((t & 63) == 0) red[t >> 6] = s; __syncthreads();
    if (t == 0) SQ0[r] = red[0] + red[1] + red[2] + red[3];
}
__global__ void k_s5tables(Prm p) {
    const int i = blockIdx.x * blockDim.x + threadIdx.x; if (i >= NG5 * NP5) return;
    const int g = i / NP5, pp = i % NP5;
    const double lre = p.in[I_LRE][i], lim = p.in[I_LIM][i], dt = exp((double)p.in[I_LOGDT][g]);
    const double er = exp(lre * dt), lbr = er * cos(lim * dt), lbi = er * sin(lim * dt);
    const double e64 = exp(64.0 * lre * dt), l64r = e64 * cos(64.0 * lim * dt), l64i = e64 * sin(64.0 * lim * dt);
    float* LAMB = (float*)(p.ws + WS_LAMB); float* LAM64 = (float*)(p.ws + WS_LAM64);
    LAMB[2 * i] = (float)lbr; LAMB[2 * i + 1] = (float)lbi; LAM64[2 * i] = (float)l64r; LAM64[2 * i + 1] = (float)l64i;
    const double nr = lbr - 1.0, ni = lbi, dd = lre * lre + lim * lim;
    const double cr = (nr * lre + ni * lim) / dd, ci = (ni * lre - nr * lim) / dd;
    float* BBF = (float*)(p.ws + WS_BBF); bf16* BB = (bf16*)(p.ws + WS_BB); bf16* CMB = (bf16*)(p.ws + WS_CMB);
    for (int h = 0; h < NH5; ++h) {
        const double br = p.in[I_BRE][(size_t)i * NH5 + h], bi = p.in[I_BIM][(size_t)i * NH5 + h];
        const float xr = (float)(cr * br - ci * bi), xi = (float)(cr * bi + ci * br);
        BBF[((size_t)i * NH5 + h) * 2] = xr; BBF[((size_t)i * NH5 + h) * 2 + 1] = xi;
        BB[((size_t)g * 128 + pp) * 16 + h] = (bf16)f2bf(xr); BB[((size_t)g * 128 + 64 + pp) * 16 + h] = (bf16)f2bf(xi);
        const float c_re = p.in[I_CRE][((size_t)g * NH5 + h) * NP5 + pp], c_im = p.in[I_CIM][((size_t)g * NH5 + h) * NP5 + pp];
        CMB[((size_t)g * 16 + h) * 128 + pp] = (bf16)f2bf(c_re); CMB[((size_t)g * 16 + h) * 128 + 64 + pp] = (bf16)f2bf(-c_im);
    }
}
__global__ void k_gwt(Prm p) {
    const int i = blockIdx.x * blockDim.x + threadIdx.x; if (i >= 16 * 3072) return;
    const int row = i / 3072, c = i % 3072; float v = 0.f;
    if (row < 4) v = p.in[I_IGW][(size_t)c * 4 + row]; else if (row < 8) v = p.in[I_FGW][(size_t)c * 4 + row - 4];
    ((bf16*)(p.ws + WS_GWT))[i] = (bf16)f2bf(v);
}

__device__ __forceinline__ int colj(int tx, int j) { return (tx >> 1) * 8 + (tx & 1) * 2 + (j & 1) + (j >> 1) * 4; }
template <class Epi>
__global__ void __launch_bounds__(256) k_gemm(const bf16* A, int lda, const bf16* Bt, int ldb, int M, int N, int K, Epi epi) {
    __shared__ float As[64][33], Bs[64][33];
    const int t = threadIdx.x, tx = t & 15, ty = t >> 4;
    const int m0 = blockIdx.y * 64, n0 = blockIdx.x * 64;
    float acc[4][4];
#pragma unroll
    for (int i = 0; i < 4; ++i)
#pragma unroll
        for (int j = 0; j < 4; ++j) acc[i][j] = 0.f;
    for (int k0 = 0; k0 < K; k0 += 32) {
        for (int e = t; e < 64 * 32; e += 256) { const int rr = e >> 5, kk = e & 31;
            As[rr][kk] = bf2f(A[(size_t)(m0 + rr) * lda + k0 + kk]); Bs[rr][kk] = bf2f(Bt[(size_t)(n0 + rr) * ldb + k0 + kk]); }
        __syncthreads();
#pragma unroll 8
        for (int kk = 0; kk < 32; ++kk) {
            float a[4], b[4];
#pragma unroll
            for (int i = 0; i < 4; ++i) a[i] = As[ty * 4 + i][kk];
#pragma unroll
            for (int j = 0; j < 4; ++j) b[j] = Bs[colj(tx, j)][kk];
#pragma unroll
            for (int i = 0; i < 4; ++i)
#pragma unroll
                for (int j = 0; j < 4; ++j) acc[i][j] += a[i] * b[j];
        }
        __syncthreads();
    }
    epi(m0 + ty * 4, n0, tx, acc);
}
struct EpiSwiglu {
    Prm p; const float* SQ; bf16* H;
    __device__ void operator()(int mb, int n0, int tx, float (&acc)[4][4]) const {
        for (int i = 0; i < 4; ++i) { const int m = mb + i; const float rs = rstd_of(SQ[m]);
            for (int jj = 0; jj < 2; ++jj) { const int c = n0 + colj(tx, jj); const float g = acc[i][jj] * rs, u = acc[i][jj + 2] * rs;
                H[(size_t)m * FF + ((c >> 3) * 4 + (c & 3))] = (bf16)f2bf(siluf(g) * u); } }
    }
};
struct EpiResid {
    Prm p; int first;    float scale; const float* SQrow;   float* SQacc; bf16* XB; int final_; int pad_;
    __device__ void operator()(int mb, int n0, int tx, float (&acc)[4][4]) const {
        for (int i = 0; i < 4; ++i) { const int m = mb + i; float* xr = xrow(p, m); const float* src = first ? xsrc_row(p, m) : xr; const float rs = SQrow ? rstd_of(SQrow[m]) : 1.f;
            for (int j = 0; j < 4; ++j) { const int n = n0 + colj(tx, j); const float xo = src ? src[n] : 0.f; const float xn = xo + scale * rs * acc[i][j];
                xr[n] = xn; if (final_) { if (XB) XB[(size_t)m * D + n] = (bf16)f2bf(xn); atomicAdd(SQacc + m, xn * xn); } } }
    }
};
struct EpiWin {
    Prm p; const float* SQ;
    __device__ void operator()(int mb, int n0, int tx, float (&acc)[4][4]) const {
        bf16* U = (bf16*)(p.ws + WS_U); bf16* XM = (bf16*)(p.ws + WS_XM); bf16* Z = (bf16*)(p.ws + WS_Z);
        for (int i = 0; i < 4; ++i) { const int m = mb + i; const float rs = rstd_of(SQ[m]);
            for (int j = 0; j < 4; ++j) { const int n = n0 + colj(tx, j); const unsigned v = f2bf(acc[i][j] * rs);
                if (n < 1024) U[(size_t)m * D + n] = (bf16)v; else if (n < 2048) XM[(size_t)m * D + n - 1024] = (bf16)v; else Z[(size_t)m * D + n - 2048] = (bf16)v; } }
    }
};
struct EpiGlu {
    Prm p;
    __device__ void operator()(int mb, int n0, int tx, float (&acc)[4][4]) const {
        const bf16* G = (const bf16*)(p.ws + WS_U); bf16* Y5 = (bf16*)(p.ws + WS_XM); float* SQ5 = (float*)(p.ws + WS_SQ5);
        for (int i = 0; i < 4; ++i) { const int m = mb + i;
            for (int j = 0; j < 4; ++j) { const int n = n0 + colj(tx, j); const float g = bf2f(G[(size_t)m * D + n]); const float y = g * sigmf(acc[i][j] + p.in[I_GLUB][n]);
                Y5[(size_t)m * D + n] = (bf16)f2bf(y); atomicAdd(SQ5 + m, y * y); } }
    }
};
__global__ void __launch_bounds__(256) k_gates(Prm p) {
    const int r = blockIdx.x, b = threadIdx.x;
    const bf16* XM = (const bf16*)(p.ws + WS_XM); bf16* KB = (bf16*)(p.ws + WS_XB);
    float* IG = (float*)(p.ws + WS_IG); float* LF = (float*)(p.ws + WS_LF);
    __shared__ float red[4][8];
    float xc[4], xm[4];
    for (int i = 0; i < 4; ++i) { const int ch = 4 * b + i; float a = p.in[I_CONVB][ch];
        for (int j = 0; j < 4; ++j) a += p.in[I_CONVW][(size_t)j * D + ch] * xm_at(p, XM, r, 3 - j, ch);
        xc[i] = siluf(a); xm[i] = xm_at(p, XM, r, 0, ch); }
    float g8[8]; for (int h = 0; h < 8; ++h) g8[h] = 0.f;
    unsigned kq[4];
    for (int o = 0; o < 4; ++o) { float q = 0.f, k = 0.f, v = 0.f;
        for (int i = 0; i < 4; ++i) { q += xc[i] * p.in[I_WQ][((size_t)b * 4 + i) * 4 + o]; k += xc[i] * p.in[I_WK][((size_t)b * 4 + i) * 4 + o]; v += xm[i] * p.in[I_WV][((size_t)b * 4 + i) * 4 + o]; }
        kq[o] = f2bf(k * 0.0625f);
        const int c = 4 * b + o;
        for (int h = 0; h < 4; ++h) { g8[h] += q * p.in[I_IGW][(size_t)c * 4 + h] + k * p.in[I_IGW][(size_t)(1024 + c) * 4 + h] + v * p.in[I_IGW][(size_t)(2048 + c) * 4 + h];
                                      g8[4 + h] += q * p.in[I_FGW][(size_t)c * 4 + h] + k * p.in[I_FGW][(size_t)(1024 + c) * 4 + h] + v * p.in[I_FGW][(size_t)(2048 + c) * 4 + h]; } }
    for (int o = 0; o < 4; ++o) KB[(size_t)r * D + 4 * b + o] = (bf16)kq[o];
    for (int h = 0; h < 8; ++h) { const float s = wave_sum(g8[h]); if ((b & 63) == 0) red[b >> 6][h] = s; }
    __syncthreads();
    if (b < 8) { const float s = red[0][b] + red[1][b] + red[2][b] + red[3][b]; const bool pad = row_is_pad(r);
        if (b < 4) IG[(size_t)r * 4 + b] = pad ? -1e30f : s + p.in[I_IGB][b]; else LF[(size_t)r * 4 + b - 4] = pad ? 0.f : logsigf(s + p.in[I_FGB][b - 4]); }
}
__global__ void k_convout(Prm p) {
    const int i = blockIdx.x * blockDim.x + threadIdx.x; const bf16* XM = (const bf16*)(p.ws + WS_XM);
    if (i < NB * 3 * D) { const int b = i / (3 * D), j = (i / D) % 3, c = i % D; p.out[O_PCONV + i] = bf2f(XM[(size_t)(b * SLOT + SLOT - 3 + j) * D + c]); }
    else if (i < NB * 3 * D + NSTR * 3 * D) { const int k = i - NB * 3 * D; const int s = k / (3 * D), j = (k / D) % 3, c = k % D; p.out[O_SCONV + k] = bf2f(XM[(size_t)(SROW0 + s * TS + TS - 3 + j) * D + c]); }
}
__global__ void __launch_bounds__(64) k_s5(Prm p) {
    const int chain = blockIdx.y, g = blockIdx.x, pp = threadIdx.x;
    bf16* U = (bf16*)(p.ws + WS_U);
    const float* LAMB = (const float*)(p.ws + WS_LAMB); const float* BBF = (const float*)(p.ws + WS_BBF);
    const float lr = LAMB[2 * (g * 64 + pp)], li = LAMB[2 * (g * 64 + pp) + 1];
    float bbr[16], bbi[16], cr[16], ci[16];
#pragma unroll
    for (int h = 0; h < 16; ++h) { bbr[h] = BBF[((size_t)(g * 64 + pp) * 16 + h) * 2]; bbi[h] = BBF[((size_t)(g * 64 + pp) * 16 + h) * 2 + 1];
        cr[h] = p.in[I_CRE][((size_t)g * 16 + h) * 64 + pp]; ci[h] = p.in[I_CIM][((size_t)g * 16 + h) * 64 + pp]; }
    int r0, nrow; float sr = 0.f, si = 0.f;
    if (chain < NB) { r0 = chain * SLOT + PADL; nrow = SLOT - PADL; }
    else { const int j = chain - NB; r0 = SROW0 + j * TS; nrow = TS; sr = p.in[I_S5RE][((size_t)j * 64 + g) * 64 + pp]; si = p.in[I_S5IM][((size_t)j * 64 + g) * 64 + pp]; }
    const float dsk = pp < 16 ? p.in[I_S5D][g * 16 + pp] : 0.f;
    for (int t = 0; t < nrow; ++t) {
        const size_t off = (size_t)(r0 + t) * D + g * 16;
        float u[16];
#pragma unroll
        for (int h = 0; h < 16; ++h) u[h] = bf2f(U[off + h]);
        float br = 0.f, bi = 0.f;
#pragma unroll
        for (int h = 0; h < 16; ++h) { br += bbr[h] * u[h]; bi += bbi[h] * u[h]; }
        const float nr = lr * sr - li * si + br, ni = lr * si + li * sr + bi; sr = nr; si = ni;
        float ymine = 0.f, umine = 0.f;
#pragma unroll
        for (int h = 0; h < 16; ++h) { const float s = wave_sum(cr[h] * sr - ci[h] * si); if (pp == h) { ymine = s; umine = u[h]; } }
        __builtin_amdgcn_wave_barrier();
        if (pp < 16) U[off + pp] = (bf16)f2bf(geluf(ymine + dsk * umine));
    }
    if (chain < NB) { p.out[O_PS5R + ((size_t)chain * 64 + g) * 64 + pp] = sr; p.out[O_PS5I + ((size_t)chain * 64 + g) * 64 + pp] = si; }
    else { const int j = chain - NB; p.out[O_SS5R + ((size_t)j * 64 + g) * 64 + pp] = sr; p.out[O_SS5I + ((size_t)j * 64 + g) * 64 + pp] = si; }
}
__global__ void __launch_bounds__(1024) k_mlstm(Prm p) {
    const int chain = blockIdx.y, hd = blockIdx.x, t = threadIdx.x, kk = t & 255, vq = t >> 8, lane = t & 63;
    const bf16* XM = (const bf16*)(p.ws + WS_XM); bf16* Z = (bf16*)(p.ws + WS_Z);
    const float* IG = (const float*)(p.ws + WS_IG); const float* LF = (const float*)(p.ws + WS_LF); float* SQM = (float*)(p.ws + WS_SQM);
    __shared__ float xc_s[256], xm_s[256], q_s[256], k_s[256], v_s[256], num_s[256], red[32];
    __shared__ float den_s, mu_s, var_s;
    float C[64]; float n = 0.f, m = 0.f;
    int r0, nrow;
    if (chain < NB) { r0 = chain * SLOT + PADL; nrow = SLOT - PADL;
#pragma unroll
        for (int i = 0; i < 64; ++i) C[i] = 0.f; }
    else { const int j = chain - NB; r0 = SROW0 + j * TS; nrow = TS;
#pragma unroll
        for (int i = 0; i < 64; ++i) C[i] = p.in[I_MLC][(((size_t)j * 4 + hd) * 256 + vq * 64 + i) * 256 + kk];
        n = p.in[I_MLN][((size_t)j * 4 + hd) * 256 + kk]; m = p.in[I_MLM][j * 4 + hd]; }
    const int ch = hd * 256 + kk;
    for (int s = 0; s < nrow; ++s) {
        const int r = r0 + s;
        if (vq == 0) { float a = p.in[I_CONVB][ch];
            for (int j = 0; j < 4; ++j) a += p.in[I_CONVW][(size_t)j * D + ch] * xm_at(p, XM, r, 3 - j, ch);
            xc_s[kk] = siluf(a); xm_s[kk] = xm_at(p, XM, r, 0, ch); num_s[kk] = 0.f; }
        if (t == 0) den_s = 0.f;
        __syncthreads();
        if (vq == 0) { const int b = kk >> 2, o = kk & 3, gb = hd * 64 + b; float q = 0.f, k = 0.f, v = 0.f;
            for (int i = 0; i < 4; ++i) { q += xc_s[4 * b + i] * p.in[I_WQ][((size_t)gb * 4 + i) * 4 + o]; k += xc_s[4 * b + i] * p.in[I_WK][((size_t)gb * 4 + i) * 4 + o]; v += xm_s[4 * b + i] * p.in[I_WV][((size_t)gb * 4 + i) * 4 + o]; }
            q_s[kk] = q; k_s[kk] = k * 0.0625f; v_s[kk] = v; }
        __syncthreads();
        const float ig = IG[(size_t)r * 4 + hd], lf = LF[(size_t)r * 4 + hd];
        const float mn = fmaxf(lf + m, ig), fp = __expf(lf + m - mn), ip = __expf(ig - mn); m = mn;
        const float kv = k_s[kk], qv = q_s[kk];
#pragma unroll
        for (int i = 0; i < 64; ++i) { C[i] = fp * C[i] + ip * v_s[vq * 64 + i] * kv; const float s2 = wave_sum(C[i] * qv); if (lane == 0) atomicAdd(&num_s[vq * 64 + i], s2); }
        if (vq == 0) { n = fp * n + ip * kv; const float s2 = wave_sum(n * qv); if (lane == 0) atomicAdd(&den_s, s2); }
        __syncthreads();
        float hv = 0.f;
        if (vq == 0) { hv = num_s[kk] / fmaxf(fabsf(den_s), __expf(-m)); const float s2 = wave_sum(hv); if (lane == 0) red[kk >> 6] = s2; }
        __syncthreads();
        if (t == 0) mu_s = (red[0] + red[1] + red[2] + red[3]) * (1.f / 256.f);
        __syncthreads();
        if (vq == 0) { const float d = hv - mu_s; const float s2 = wave_sum(d * d); if (lane == 0) red[8 + (kk >> 6)] = s2; }
        __syncthreads();
        if (t == 0) var_s = (red[8] + red[9] + red[10] + red[11]) * (1.f / 256.f);
        __syncthreads();
        if (vq == 0) { const float hn = (hv - mu_s) * rsqrtf(var_s + EPS) * p.in[I_MLNORM][ch]; const float zz = bf2f(Z[(size_t)r * D + ch]);
            const float o = (hn + p.in[I_SKIP][ch] * xc_s[kk]) * siluf(zz); Z[(size_t)r * D + ch] = (bf16)f2bf(o);
            const float s2 = wave_sum(o * o); if (lane == 0) atomicAdd(SQM + r, s2); }
        __syncthreads();
    }
    if (chain < NB) {
#pragma unroll
        for (int i = 0; i < 64; ++i) p.out[O_PC + (((size_t)chain * 4 + hd) * 256 + vq * 64 + i) * 256 + kk] = C[i];
        if (vq == 0) p.out[O_PN + ((size_t)chain * 4 + hd) * 256 + kk] = n; if (t == 0) p.out[O_PM + chain * 4 + hd] = m;
    } else { const int j = chain - NB;
#pragma unroll
        for (int i = 0; i < 64; ++i) p.out[O_SC + (((size_t)j * 4 + hd) * 256 + vq * 64 + i) * 256 + kk] = C[i];
        if (vq == 0) p.out[O_SN + ((size_t)j * 4 + hd) * 256 + kk] = n; if (t == 0) p.out[O_SM + j * 4 + hd] = m; }
}
__global__ void __launch_bounds__(256) k_final(Prm p) {
    const int r = blockIdx.x; if (r < SROW0) { const int tp = r >= SLOT ? r - SLOT : r; if (tp < 256) return; }
    float* xr = xrow(p, r); const float rs = rstd_of(((const float*)(p.ws + WS_SQ3))[r]);
    for (int c = threadIdx.x; c < D; c += 256) xr[c] = xr[c] * rs * p.in[I_NORMF][c];
}
}
extern "C" void kernel_launch(void* const* d_in, const int* in_sizes, int n_in, void* d_out, int out_size, void* d_ws, size_t ws_size, hipStream_t stream) {
    if (n_in != N_IN || out_size != (int)O_END || ws_size < WS_END) { fprintf(stderr, "kernel_launch: unexpected sizes n_in %d out %d ws %zu\n", n_in, out_size, ws_size); return; }
    Prm p{}; for (int i = 0; i < N_IN; ++i) p.in[i] = (const float*)d_in[i]; p.out = (float*)d_out; p.ws = (unsigned char*)d_ws;
    unsigned char* ws = p.ws;
    hipMemsetAsync(ws + WS_CTL, 0, CTL_ZERO_BYTES, stream);
    nv::k_transpose<<<2048, 256, 0, stream>>>(p.in[I_G1], D, FF, (bf16*)(ws + WS_W1GU), D, 1, p.in[I_NORM1], nullptr, D);
    nv::k_transpose<<<2048, 256, 0, stream>>>(p.in[I_U1], D, FF, (bf16*)(ws + WS_W1GU), D, 2, p.in[I_NORM1], nullptr, D);
    nv::k_transpose<<<2048, 256, 0, stream>>>(p.in[I_D1], FF, D, (bf16*)(ws + WS_W1D), FF, 0, nullptr, nullptr, 0);
    nv::k_transpose<<<2048, 256, 0, stream>>>(p.in[I_WIN], D, NPROJ, (bf16*)(ws + WS_WIN), D, 0, p.in[I_NORMMIX], nullptr, D);
    nv::k_transpose<<<2048, 256, 0, stream>>>(p.in[I_GLUW], D, D, (bf16*)(ws + WS_WGLU), D, 0, nullptr, nullptr, 0);
    nv::k_transpose<<<2048, 256, 0, stream>>>(p.in[I_WOUT], 2 * D, D, (bf16*)(ws + WS_WOUT), 2 * D, 0, p.in[I_ONS5], p.in[I_ONML], D);
    nv::k_transpose<<<2048, 256, 0, stream>>>(p.in[I_G2], D, FF, (bf16*)(ws + WS_W2GU), D, 1, p.in[I_NORM2], nullptr, D);
    nv::k_transpose<<<2048, 256, 0, stream>>>(p.in[I_U2], D, FF, (bf16*)(ws + WS_W2GU), D, 2, p.in[I_NORM2], nullptr, D);
    nv::k_transpose<<<2048, 256, 0, stream>>>(p.in[I_D2], FF, D, (bf16*)(ws + WS_W2D), FF, 0, nullptr, nullptr, 0);
    nv::k_rows0<<<MR, 256, 0, stream>>>(p);
    nv::k_s5tables<<<16, 256, 0, stream>>>(p);
    nv::k_gwt<<<192, 256, 0, stream>>>(p);
    const bf16* XB = (const bf16*)(ws + WS_XB); const bf16* H = (const bf16*)(ws + WS_H);
    nv::k_gemm<<<dim3(2 * FF / 64, MR / 64), 256, 0, stream>>>(XB, D, (const bf16*)(ws + WS_W1GU), D, MR, 2 * FF, D, nv::EpiSwiglu{p, (const float*)(ws + WS_SQ0), (bf16*)(ws + WS_H)});
    nv::k_gemm<<<dim3(D / 64, MR / 64), 256, 0, stream>>>(H, FF, (const bf16*)(ws + WS_W1D), FF, MR, D, FF, nv::EpiResid{p, 1, 0.5f, nullptr, (float*)(ws + WS_SQ1), (bf16*)(ws + WS_XB), 1, 0});
    nv::k_gemm<<<dim3(NPROJ / 64, MR / 64), 256, 0, stream>>>(XB, D, (const bf16*)(ws + WS_WIN), D, MR, NPROJ, D, nv::EpiWin{p, (const float*)(ws + WS_SQ1)});
    nv::k_gates<<<MR, 256, 0, stream>>>(p);
    nv::k_convout<<<(NB * 3 * D + NSTR * 3 * D + 255) / 256, 256, 0, stream>>>(p);
    nv::k_s5<<<dim3(64, NB + NSTR), 64, 0, stream>>>(p);
    nv::k_mlstm<<<dim3(4, NB + NSTR), 1024, 0, stream>>>(p);
    nv::k_gemm<<<dim3(D / 64, MR / 64), 256, 0, stream>>>((const bf16*)(ws + WS_U), D, (const bf16*)(ws + WS_WGLU), D, MR, D, D, nv::EpiGlu{p});
    nv::k_gemm<<<dim3(D / 64, MR / 64), 256, 0, stream>>>((const bf16*)(ws + WS_XM), D, (const bf16*)(ws + WS_WOUT), 2 * D, MR, D, D, nv::EpiResid{p, 0, 1.f, (const float*)(ws + WS_SQ5), nullptr, nullptr, 0, 0});
    nv::k_gemm<<<dim3(D / 64, MR / 64), 256, 0, stream>>>((const bf16*)(ws + WS_Z), D, (const bf16*)(ws + WS_WOUT) + D, 2 * D, MR, D, D, nv::EpiResid{p, 0, 1.f, (const float*)(ws + WS_SQM), (float*)(ws + WS_SQ2), (bf16*)(ws + WS_XB), 1, 0});
    nv::k_gemm<<<dim3(2 * FF / 64, MR / 64), 256, 0, stream>>>(XB, D, (const bf16*)(ws + WS_W2GU), D, MR, 2 * FF, D, nv::EpiSwiglu{p, (const float*)(ws + WS_SQ2), (bf16*)(ws + WS_H)});
    nv::k_gemm<<<dim3(D / 64, MR / 64), 256, 0, stream>>>(H, FF, (const bf16*)(ws + WS_W2D), FF, MR, D, FF, nv::EpiResid{p, 0, 0.5f, nullptr, (float*)(ws + WS_SQ3), nullptr, 1, 0});
    nv::k_final<<<MR, 256, 0, stream>>>(p);
}
```

```cpp
#include <hip/hip_runtime.h>
#include <cstdio>
#include <cstdint>

constexpr int D = 1024, FF = 2816, NPROJ = 3072, SEQ = 8192, NB = 2, NMETA = 16, NSTR = 16, TS = 32;
constexpr int SLOT = 8448, PADL = 240;
constexpr int MR = NB * SLOT + NSTR * TS;
constexpr int SROW0 = NB * SLOT;
constexpr int NG5 = 64, NP5 = 64, NH5 = 16;
constexpr int NHEAD = 4, HD = 256;
constexpr float EPS = 1e-6f;
constexpr int NSEG = NB * (SLOT / 256) + NSTR;
constexpr int NCH64 = MR / 64;

enum { I_XP = 0, I_XS, I_S5RE, I_S5IM, I_MLC, I_MLN, I_MLM, I_MLCONV, I_META, I_NORM1, I_G1, I_U1, I_D1, I_NORMMIX, I_WIN,
       I_LRE, I_LIM, I_LOGDT, I_BRE, I_BIM, I_CRE, I_CIM, I_S5D, I_GLUW, I_GLUB, I_CONVW, I_CONVB, I_WQ, I_WK, I_WV, I_IGW, I_IGB, I_FGW, I_FGB,
       I_MLNORM, I_SKIP, I_ONS5, I_ONML, I_WOUT, I_NORM2, I_G2, I_U2, I_D2, I_NORMF, N_IN };

constexpr size_t O_YP = 0, O_YS = 16777216, O_PS5R = 17301504, O_PS5I = 17309696, O_PC = 17317888, O_PN = 17842176, O_PM = 17844224, O_PCONV = 17844232,
                 O_SS5R = 17850376, O_SS5I = 17915912, O_SC = 17981448, O_SN = 22175752, O_SM = 22192136, O_SCONV = 22192200, O_END = 22241352;

constexpr size_t MiB = 1u << 20;
constexpr size_t WS_CTL = 0, CTL_ZERO_BYTES = 1 * MiB;
constexpr size_t SQ_BYTES = (size_t)MR * 4;
constexpr size_t WS_SQ1 = 128 * 1024, WS_SQ2 = WS_SQ1 + SQ_BYTES, WS_SQ3 = WS_SQ2 + SQ_BYTES, WS_SQ5 = WS_SQ3 + SQ_BYTES, WS_SQM = WS_SQ5 + SQ_BYTES;
static_assert(WS_SQM + SQ_BYTES <= CTL_ZERO_BYTES, "zeroed region");
constexpr size_t WS_TBL = 1 * MiB;
constexpr size_t WS_SQ0 = WS_TBL;
constexpr size_t WS_LAMB = WS_TBL + 128 * 1024;
constexpr size_t WS_LAM64 = WS_LAMB + 32 * 1024;
constexpr size_t WS_BBF = WS_TBL + 256 * 1024;
constexpr size_t WS_BB = WS_TBL + 768 * 1024;
constexpr size_t WS_CMB = WS_TBL + 1024 * 1024;
constexpr size_t WS_GWT = WS_TBL + 1280 * 1024;
constexpr size_t WS_W1GU = 4 * MiB, WS_W1D = 15 * MiB, WS_WIN = 21 * MiB, WS_WGLU = 27 * MiB, WS_WOUT = 29 * MiB, WS_W2GU = 33 * MiB, WS_W2D = 44 * MiB;
constexpr size_t WS_XB = 50 * MiB;
constexpr size_t WS_U = 84 * MiB, WS_XM = 118 * MiB, WS_Z = 152 * MiB;
constexpr size_t WS_H = 84 * MiB;
constexpr size_t WS_CS = 186 * MiB;
constexpr size_t WS_DS = 227 * MiB;
constexpr size_t WS_XSIDE = 236 * MiB;
constexpr size_t WS_IG = 238 * MiB, WS_LF = WS_IG + (size_t)MR * 16, WS_BC = WS_LF + (size_t)MR * 16, WS_AA = WS_BC + (size_t)MR * 16, WS_AM = WS_AA + (size_t)MR * 16;
constexpr size_t WS_NS = 240 * MiB;
constexpr size_t WS_SEGS = WS_NS + (size_t)NSEG * 4 * 256 * 4;
constexpr size_t WS_END = 241 * MiB;
static_assert(WS_H + (size_t)MR * FF * 2 <= WS_CS && WS_CS + (size_t)NSEG * 4 * 65536 * 2 <= WS_DS && WS_DS + (size_t)NCH64 * 4096 * 8 <= WS_XSIDE && WS_AM + (size_t)MR * 16 <= WS_NS && WS_SEGS + NSEG * 64 <= WS_END, "ws map");
static_assert(WS_W2D + (size_t)D * FF * 2 <= WS_XB && WS_W1GU + (size_t)2 * FF * D * 2 <= WS_W1D && WS_GWT + 16 * 3072 * 2 <= WS_W1GU, "ws map 2");

typedef unsigned short bf16;
__device__ __forceinline__ float bf2f(bf16 v) { return __uint_as_float((unsigned)v << 16); }
__device__ __forceinline__ unsigned f2bf(float f) { unsigned u = __float_as_uint(f); return (u + 0x7fffu + ((u >> 16) & 1u)) >> 16; }
__device__ __forceinline__ unsigned pk2(float lo, float hi) { return f2bf(lo) | (f2bf(hi) << 16); }
__device__ __forceinline__ float siluf(float x) { return x / (1.f + __expf(-x)); }
__device__ __forceinline__ float sigmf(float x) { return 1.f / (1.f + __expf(-x)); }
__device__ __forceinline__ float logsigf(float x) { return x >= 0.f ? -log1pf(__expf(-x)) : x - log1pf(__expf(x)); }
__device__ __forceinline__ float geluf(float x) { const float t = tanhf(0.7978845608028654f * (x + 0.044715f * x * x * x)); return 0.5f * x * (1.f + t); }

struct Prm { const float* in[N_IN]; float* out; unsigned char* ws; };

__device__ __forceinline__ const float* xsrc_row(const Prm& p, int r) {
    if (r >= SROW0) return p.in[I_XS] + (size_t)(r - SROW0) * D;
    const int b = r >= SLOT ? 1 : 0, tp = r - b * SLOT;
    if (tp < PADL) return nullptr;
    if (tp < 256) return p.in[I_META] + (size_t)(tp - PADL) * D;
    return p.in[I_XP] + ((size_t)b * SEQ + (tp - 256)) * D;
}
__device__ __forceinline__ float* xrow(const Prm& p, int r) {
    if (r >= SROW0) return p.out + O_YS + (size_t)(r - SROW0) * D;
    const int b = r >= SLOT ? 1 : 0, tp = r - b * SLOT;
    if (tp < 256) return (float*)(p.ws + WS_XSIDE) + (size_t)(b * 256 + tp) * D;
    return p.out + O_YP + ((size_t)b * SEQ + (tp - 256)) * D;
}
__device__ __forceinline__ bool row_is_pad(int r) { if (r >= SROW0) return false; const int tp = r >= SLOT ? r - SLOT : r; return tp < PADL; }
__device__ __forceinline__ float xm_at(const Prm& p, const bf16* XM, int r, int back, int ch) {
    if (r >= SROW0) { const int j = (r - SROW0) / TS, t = (r - SROW0) % TS - back; if (t >= 0) return bf2f(XM[(size_t)(r - back) * D + ch]); return p.in[I_MLCONV][((size_t)j * 3 + (3 + t)) * D + ch]; }
    const int b = r >= SLOT ? 1 : 0, tp = r - b * SLOT - back;
    if (tp < 0) return 0.f;
    return bf2f(XM[(size_t)(r - back) * D + ch]);
}
__device__ __forceinline__ float rstd_of(float sumsq) { return rsqrtf(sumsq * (1.0f / D) + EPS); }
__device__ __forceinline__ float wave_sum(float v) {
#pragma unroll
    for (int o = 1; o < 64; o <<= 1) v += __shfl_xor(v, o);
    return v;
}
namespace nv {
__global__ void k_transpose(const float* W, int K, int N, bf16* WT, int ldt, int rowmode, const float* scaleA, const float* scaleB, int splitK) {
    const size_t total = (size_t)K * N;
    for (size_t idx = (size_t)blockIdx.x * blockDim.x + threadIdx.x; idx < total; idx += (size_t)gridDim.x * blockDim.x) {
        const int n = (int)(idx / K), k = (int)(idx % K);
        const int dr = rowmode == 0 ? n : ((n >> 2) * 8 + (n & 3) + (rowmode == 2 ? 4 : 0));
        float s = 1.f; if (scaleA) s = (k < splitK) ? scaleA[k] : scaleB[k - splitK];
        WT[(size_t)dr * ldt + k] = (bf16)f2bf(W[(size_t)k * N + n] * s);
    }
}
__global__ void k_rows0(Prm p) {
    const int r = blockIdx.x, t = threadIdx.x;
    const float* src = xsrc_row(p, r);
    bf16* XB = (bf16*)(p.ws + WS_XB); float* SQ0 = (float*)(p.ws + WS_SQ0);
    __shared__ float red[4];
    float s = 0.f;
    for (int c = t; c < D; c += 256) { const float v = src ? src[c] : 0.f; XB[(size_t)r * D + c] = (bf16)f2bf(v); s += v * v; }
    s = wave_sum(s); if ((t & 63) == 0) red[t >> 6] = s; __syncthreads();
    if (t == 0) SQ0[r] = red[0] + red[1] + red[2] + red[3];
}
__global__ void k_s5tables(Prm p) {
    const int i = blockIdx.x * blockDim.x + threadIdx.x; if (i >= NG5 * NP5) return;
    const int g = i / NP5, pp = i % NP5;
    const double lre = p.in[I_LRE][i], lim = p.in[I_LIM][i], dt = exp((double)p.in[I_LOGDT][g]);
    const double er = exp(lre * dt), lbr = er * cos(lim * dt), lbi = er * sin(lim * dt);
    const double e64 = exp(64.0 * lre * dt), l64r = e64 * cos(64.0 * lim * dt), l64i = e64 * sin(64.0 * lim * dt);
    float* LAMB = (float*)(p.ws + WS_LAMB); float* LAM64 = (float*)(p.ws + WS_LAM64);
    LAMB[2 * i] = (float)lbr; LAMB[2 * i + 1] = (float)lbi; LAM64[2 * i] = (float)l64r; LAM64[2 * i + 1] = (float)l64i;
    const double nr = lbr - 1.0, ni = lbi, dd = lre * lre + lim * lim;
    const double cr = (nr * lre + ni * lim) / dd, ci = (ni * lre - nr * lim) / dd;
    float* BBF = (float*)(p.ws + WS_BBF); bf16* BB = (bf16*)(p.ws + WS_BB); bf16* CMB = (bf16*)(p.ws + WS_CMB);
    for (int h = 0; h < NH5; ++h) {
        const double br = p.in[I_BRE][(size_t)i * NH5 + h], bi = p.in[I_BIM][(size_t)i * NH5 + h];
        const float xr = (float)(cr * br - ci * bi), xi = (float)(cr * bi + ci * br);
        BBF[((size_t)i * NH5 + h) * 2] = xr; BBF[((size_t)i * NH5 + h) * 2 + 1] = xi;
        BB[((size_t)g * 128 + pp) * 16 + h] = (bf16)f2bf(xr); BB[((size_t)g * 128 + 64 + pp) * 16 + h] = (bf16)f2bf(xi);
        const float c_re = p.in[I_CRE][((size_t)g * NH5 + h) * NP5 + pp], c_im = p.in[I_CIM][((size_t)g * NH5 + h) * NP5 + pp];
        CMB[((size_t)g * 16 + h) * 128 + pp] = (bf16)f2bf(c_re); CMB[((size_t)g * 16 + h) * 128 + 64 + pp] = (bf16)f2bf(-c_im);
    }
}
__global__ void k_gwt(Prm p) {
    const int i = blockIdx.x * blockDim.x + threadIdx.x; if (i >= 16 * 3072) return;
    const int row = i / 3072, c = i % 3072; float v = 0.f;
    if (row < 4) v = p.in[I_IGW][(size_t)c * 4 + row]; else if (row < 8) v = p.in[I_FGW][(size_t)c * 4 + row - 4];
    ((bf16*)(p.ws + WS_GWT))[i] = (bf16)f2bf(v);
}

__device__ __forceinline__ int colj(int tx, int j) { return (tx >> 1) * 8 + (tx & 1) * 2 + (j & 1) + (j >> 1) * 4; }
template <class Epi>
__global__ void __launch_bounds__(256) k_gemm(const bf16* A, int lda, const bf16* Bt, int ldb, int M, int N, int K, Epi epi) {
    __shared__ float As[64][33], Bs[64][33];
    const int t = threadIdx.x, tx = t & 15, ty = t >> 4;
    const int m0 = blockIdx.y * 64, n0 = blockIdx.x * 64;
    float acc[4][4];
#pragma unroll
    for (int i = 0; i < 4; ++i)
#pragma unroll
        for (int j = 0; j < 4; ++j) acc[i][j] = 0.f;
    for (int k0 = 0; k0 < K; k0 += 32) {
        for (int e = t; e < 64 * 32; e += 256) { const int rr = e >> 5, kk = e & 31;
            As[rr][kk] = bf2f(A[(size_t)(m0 + rr) * lda + k0 + kk]); Bs[rr][kk] = bf2f(Bt[(size_t)(n0 + rr) * ldb + k0 + kk]); }
        __syncthreads();
#pragma unroll 8
        for (int kk = 0; kk < 32; ++kk) {
            float a[4], b[4];
#pragma unroll
            for (int i = 0; i < 4; ++i) a[i] = As[ty * 4 + i][kk];
#pragma unroll
            for (int j = 0; j < 4; ++j) b[j] = Bs[colj(tx, j)][kk];
#pragma unroll
            for (int i = 0; i < 4; ++i)
#pragma unroll
                for (int j = 0; j < 4; ++j) acc[i][j] += a[i] * b[j];
        }
        __syncthreads();
    }
    epi(m0 + ty * 4, n0, tx, acc);
}
struct EpiSwiglu {
    Prm p; const float* SQ; bf16* H;
    __device__ void operator()(int mb, int n0, int tx, float (&acc)[4][4]) const {
        for (int i = 0; i < 4; ++i) { const int m = mb + i; const float rs = rstd_of(SQ[m]);
            for (int jj = 0; jj < 2; ++jj) { const int c = n0 + colj(tx, jj); const float g = acc[i][jj] * rs, u = acc[i][jj + 2] * rs;
                H[(size_t)m * FF + ((c >> 3) * 4 + (c & 3))] = (bf16)f2bf(siluf(g) * u); } }
    }
};
struct EpiResid {
    Prm p; int first;    float scale; const float* SQrow;   float* SQacc; bf16* XB; int final_; int pad_;
    __device__ void operator()(int mb, int n0, int tx, float (&acc)[4][4]) const {
        for (int i = 0; i < 4; ++i) { const int m = mb + i; float* xr = xrow(p, m); const float* src = first ? xsrc_row(p, m) : xr; const float rs = SQrow ? rstd_of(SQrow[m]) : 1.f;
            for (int j = 0; j < 4; ++j) { const int n = n0 + colj(tx, j); const float xo = src ? src[n] : 0.f; const float xn = xo + scale * rs * acc[i][j];
                xr[n] = xn; if (final_) { if (XB) XB[(size_t)m * D + n] = (bf16)f2bf(xn); atomicAdd(SQacc + m, xn * xn); } } }
    }
};
struct EpiWin {
    Prm p; const float* SQ;
    __device__ void operator()(int mb, int n0, int tx, float (&acc)[4][4]) const {
        bf16* U = (bf16*)(p.ws + WS_U); bf16* XM = (bf16*)(p.ws + WS_XM); bf16* Z = (bf16*)(p.ws + WS_Z);
        for (int i = 0; i < 4; ++i) { const int m = mb + i; const float rs = rstd_of(SQ[m]);
            for (int j = 0; j < 4; ++j) { const int n = n0 + colj(tx, j); const unsigned v = f2bf(acc[i][j] * rs);
                if (n < 1024) U[(size_t)m * D + n] = (bf16)v; else if (n < 2048) XM[(size_t)m * D + n - 1024] = (bf16)v; else Z[(size_t)m * D + n - 2048] = (bf16)v; } }
    }
};
struct EpiGlu {
    Prm p;
    __device__ void operator()(int mb, int n0, int tx, float (&acc)[4][4]) const {
        const bf16* G = (const bf16*)(p.ws + WS_U); bf16* Y5 = (bf16*)(p.ws + WS_XM); float* SQ5 = (float*)(p.ws + WS_SQ5);
        for (int i = 0; i < 4; ++i) { const int m = mb + i;
            for (int j = 0; j < 4; ++j) { const int n = n0 + colj(tx, j); const float g = bf2f(G[(size_t)m * D + n]); const float y = g * sigmf(acc[i][j] + p.in[I_GLUB][n]);
                Y5[(size_t)m * D + n] = (bf16)f2bf(y); atomicAdd(SQ5 + m, y * y); } }
    }
};
__global__ void __launch_bounds__(256) k_gates(Prm p) {
    const int r = blockIdx.x, b = threadIdx.x;
    const bf16* XM = (const bf16*)(p.ws + WS_XM); bf16* KB = (bf16*)(p.ws + WS_XB);
    float* IG = (float*)(p.ws + WS_IG); float* LF = (float*)(p.ws + WS_LF);
    __shared__ float red[4][8];
    float xc[4], xm[4];
    for (int i = 0; i < 4; ++i) { const int ch = 4 * b + i; float a = p.in[I_CONVB][ch];
        for (int j = 0; j < 4; ++j) a += p.in[I_CONVW][(size_t)j * D + ch] * xm_at(p, XM, r, 3 - j, ch);
        xc[i] = siluf(a); xm[i] = xm_at(p, XM, r, 0, ch); }
    float g8[8]; for (int h = 0; h < 8; ++h) g8[h] = 0.f;
    unsigned kq[4];
    for (int o = 0; o < 4; ++o) { float q = 0.f, k = 0.f, v = 0.f;
        for (int i = 0; i < 4; ++i) { q += xc[i] * p.in[I_WQ][((size_t)b * 4 + i) * 4 + o]; k += xc[i] * p.in[I_WK][((size_t)b * 4 + i) * 4 + o]; v += xm[i] * p.in[I_WV][((size_t)b * 4 + i) * 4 + o]; }
        kq[o] = f2bf(k * 0.0625f);
        const int c = 4 * b + o;
        for (int h = 0; h < 4; ++h) { g8[h] += q * p.in[I_IGW][(size_t)c * 4 + h] + k * p.in[I_IGW][(size_t)(1024 + c) * 4 + h] + v * p.in[I_IGW][(size_t)(2048 + c) * 4 + h];
                                      g8[4 + h] += q * p.in[I_FGW][(size_t)c * 4 + h] + k * p.in[I_FGW][(size_t)(1024 + c) * 4 + h] + v * p.in[I_FGW][(size_t)(2048 + c) * 4 + h]; } }
    for (int o = 0; o < 4; ++o) KB[(size_t)r * D + 4 * b + o] = (bf16)kq[o];
    for (int h = 0; h < 8; ++h) { const float s = wave_sum(g8[h]); if ((b & 63) == 0) red[b >> 6][h] = s; }
    __syncthreads();
    if (b < 8) { const float s = red[0][b] + red[1][b] + red[2][b] + red[3][b]; const bool pad = row_is_pad(r);
        if (b < 4) IG[(size_t)r * 4 + b] = pad ? -1e30f : s + p.in[I_IGB][b]; else LF[(size_t)r * 4 + b - 4] = pad ? 0.f : logsigf(s + p.in[I_FGB][b - 4]); }
}
__global__ void k_convout(Prm p) {
    const int i = blockIdx.x * blockDim.x + threadIdx.x; const bf16* XM = (const bf16*)(p.ws + WS_XM);
    if (i < NB * 3 * D) { const int b = i / (3 * D), j = (i / D) % 3, c = i % D; p.out[O_PCONV + i] = bf2f(XM[(size_t)(b * SLOT + SLOT - 3 + j) * D + c]); }
    else if (i < NB * 3 * D + NSTR * 3 * D) { const int k = i - NB * 3 * D; const int s = k / (3 * D), j = (k / D) % 3, c = k % D; p.out[O_SCONV + k] = bf2f(XM[(size_t)(SROW0 + s * TS + TS - 3 + j) * D + c]); }
}
__global__ void __launch_bounds__(64) k_s5(Prm p) {
    const int chain = blockIdx.y, g = blockIdx.x, pp = threadIdx.x;
    bf16* U = (bf16*)(p.ws + WS_U);
    const float* LAMB = (const float*)(p.ws + WS_LAMB); const float* BBF = (const float*)(p.ws + WS_BBF);
    const float lr = LAMB[2 * (g * 64 + pp)], li = LAMB[2 * (g * 64 + pp) + 1];
    float bbr[16], bbi[16], cr[16], ci[16];
#pragma unroll
    for (int h = 0; h < 16; ++h) { bbr[h] = BBF[((size_t)(g * 64 + pp) * 16 + h) * 2]; bbi[h] = BBF[((size_t)(g * 64 + pp) * 16 + h) * 2 + 1];
        cr[h] = p.in[I_CRE][((size_t)g * 16 + h) * 64 + pp]; ci[h] = p.in[I_CIM][((size_t)g * 16 + h) * 64 + pp]; }
    int r0, nrow; float sr = 0.f, si = 0.f;
    if (chain < NB) { r0 = chain * SLOT + PADL; nrow = SLOT - PADL; }
    else { const int j = chain - NB; r0 = SROW0 + j * TS; nrow = TS; sr = p.in[I_S5RE][((size_t)j * 64 + g) * 64 + pp]; si = p.in[I_S5IM][((size_t)j * 64 + g) * 64 + pp]; }
    const float dsk = pp < 16 ? p.in[I_S5D][g * 16 + pp] : 0.f;
    for (int t = 0; t < nrow; ++t) {
        const size_t off = (size_t)(r0 + t) * D + g * 16;
        float u[16];
#pragma unroll
        for (int h = 0; h < 16; ++h) u[h] = bf2f(U[off + h]);
        float br = 0.f, bi = 0.f;
#pragma unroll
        for (int h = 0; h < 16; ++h) { br += bbr[h] * u[h]; bi += bbi[h] * u[h]; }
        const float nr = lr * sr - li * si + br, ni = lr * si + li * sr + bi; sr = nr; si = ni;
        float ymine = 0.f, umine = 0.f;
#pragma unroll
        for (int h = 0; h < 16; ++h) { const float s = wave_sum(cr[h] * sr - ci[h] * si); if (pp == h) { ymine = s; umine = u[h]; } }
        __builtin_amdgcn_wave_barrier();
        if (pp < 16) U[off + pp] = (bf16)f2bf(geluf(ymine + dsk * umine));
    }
    if (chain < NB) { p.out[O_PS5R + ((size_t)chain * 64 + g) * 64 + pp] = sr; p.out[O_PS5I + ((size_t)chain * 64 + g) * 64 + pp] = si; }
    else { const int j = chain - NB; p.out[O_SS5R + ((size_t)j * 64 + g) * 64 + pp] = sr; p.out[O_SS5I + ((size_t)j * 64 + g) * 64 + pp] = si; }
}
__global__ void __launch_bounds__(1024) k_mlstm(Prm p) {
    const int chain = blockIdx.y, hd = blockIdx.x, t = threadIdx.x, kk = t & 255, vq = t >> 8, lane = t & 63;
    const bf16* XM = (const bf16*)(p.ws + WS_XM); bf16* Z = (bf16*)(p.ws + WS_Z);
    const float* IG = (const float*)(p.ws + WS_IG); const float* LF = (const float*)(p.ws + WS_LF); float* SQM = (float*)(p.ws + WS_SQM);
    __shared__ float xc_s[256], xm_s[256], q_s[256], k_s[256], v_s[256], num_s[256], red[32];
    __shared__ float den_s, mu_s, var_s;
    float C[64]; float n = 0.f, m = 0.f;
    int r0, nrow;
    if (chain < NB) { r0 = chain * SLOT + PADL; nrow = SLOT - PADL;
#pragma unroll
        for (int i = 0; i < 64; ++i) C[i] = 0.f; }
    else { const int j = chain - NB; r0 = SROW0 + j * TS; nrow = TS;
#pragma unroll
        for (int i = 0; i < 64; ++i) C[i] = p.in[I_MLC][(((size_t)j * 4 + hd) * 256 + vq * 64 + i) * 256 + kk];
        n = p.in[I_MLN][((size_t)j * 4 + hd) * 256 + kk]; m = p.in[I_MLM][j * 4 + hd]; }
    const int ch = hd * 256 + kk;
    for (int s = 0; s < nrow; ++s) {
        const int r = r0 + s;
        if (vq == 0) { float a = p.in[I_CONVB][ch];
            for (int j = 0; j < 4; ++j) a += p.in[I_CONVW][(size_t)j * D + ch] * xm_at(p, XM, r, 3 - j, ch);
            xc_s[kk] = siluf(a); xm_s[kk] = xm_at(p, XM, r, 0, ch); num_s[kk] = 0.f; }
        if (t == 0) den_s = 0.f;
        __syncthreads();
        if (vq == 0) { const int b = kk >> 2, o = kk & 3, gb = hd * 64 + b; float q = 0.f, k = 0.f, v = 0.f;
            for (int i = 0; i < 4; ++i) { q += xc_s[4 * b + i] * p.in[I_WQ][((size_t)gb * 4 + i) * 4 + o]; k += xc_s[4 * b + i] * p.in[I_WK][((size_t)gb * 4 + i) * 4 + o]; v += xm_s[4 * b + i] * p.in[I_WV][((size_t)gb * 4 + i) * 4 + o]; }
            q_s[kk] = q; k_s[kk] = k * 0.0625f; v_s[kk] = v; }
        __syncthreads();
        const float ig = IG[(size_t)r * 4 + hd], lf = LF[(size_t)r * 4 + hd];
        const float mn = fmaxf(lf + m, ig), fp = __expf(lf + m - mn), ip = __expf(ig - mn); m = mn;
        const float kv = k_s[kk], qv = q_s[kk];
#pragma unroll
        for (int i = 0; i < 64; ++i) { C[i] = fp * C[i] + ip * v_s[vq * 64 + i] * kv; const float s2 = wave_sum(C[i] * qv); if (lane == 0) atomicAdd(&num_s[vq * 64 + i], s2); }
        if (vq == 0) { n = fp * n + ip * kv; const float s2 = wave_sum(n * qv); if (lane == 0) atomicAdd(&den_s, s2); }
        __syncthreads();
        float hv = 0.f;
        if (vq == 0) { hv = num_s[kk] / fmaxf(fabsf(den_s), __expf(-m)); const float s2 = wave_sum(hv); if (lane == 0) red[kk >> 6] = s2; }
        __syncthreads();
        if (t == 0) mu_s = (red[0] + red[1] + red[2] + red[3]) * (1.f / 256.f);
        __syncthreads();
        if (vq == 0) { const float d = hv - mu_s; const float s2 = wave_sum(d * d); if (lane == 0) red[8 + (kk >> 6)] = s2; }
        __syncthreads();
        if (t == 0) var_s = (red[8] + red[9] + red[10] + red[11]) * (1.f / 256.f);
        __syncthreads();
        if (vq == 0) { const float hn = (hv - mu_s) * rsqrtf(var_s + EPS) * p.in[I_MLNORM][ch]; const float zz = bf2f(Z[(size_t)r * D + ch]);
            const float o = (hn + p.in[I_SKIP][ch] * xc_s[kk]) * siluf(zz); Z[(size_t)r * D + ch] = (bf16)f2bf(o);
            const float s2 = wave_sum(o * o); if (lane == 0) atomicAdd(SQM + r, s2); }
        __syncthreads();
    }
    if (chain < NB) {
#pragma unroll
        for (int i = 0; i < 64; ++i) p.out[O_PC + (((size_t)chain * 4 + hd) * 256 + vq * 64 + i) * 256 + kk] = C[i];
        if (vq == 0) p.out[O_PN + ((size_t)chain * 4 + hd) * 256 + kk] = n; if (t == 0) p.out[O_PM + chain * 4 + hd] = m;
    } else { const int j = chain - NB;
#pragma unroll
        for (int i = 0; i < 64; ++i) p.out[O_SC + (((size_t)j * 4 + hd) * 256 + vq * 64 + i) * 256 + kk] = C[i];
        if (vq == 0) p.out[O_SN + ((size_t)j * 4 + hd) * 256 + kk] = n; if (t == 0) p.out[O_SM + j * 4 + hd] = m; }
}
__global__ void __launch_bounds__(256) k_final(Prm p) {
    const int r = blockIdx.x; if (r < SROW0) { const int tp = r >= SLOT ? r - SLOT : r; if (tp < 256) return; }
    float* xr = xrow(p, r); const float rs = rstd_of(((const float*)(p.ws + WS_SQ3))[r]);
    for (int c = threadIdx.x; c < D; c += 256) xr[c] = xr[c] * rs * p.in[I_NORMF][c];
}
}
namespace pg8 {
#define PG8_LAS __attribute__((address_space(3)))
typedef unsigned short bf16_t;
typedef short bf16x8 __attribute__((ext_vector_type(8)));
typedef float f32x4 __attribute__((ext_vector_type(4)));
typedef unsigned u32x4 __attribute__((ext_vector_type(4)));
typedef unsigned u32x2 __attribute__((ext_vector_type(2)));
constexpr int BM = 256, BK = 64, HALF = 128, HTB = HALF * BK * 2  , STAGE_BYTES = 8 * HTB, NXCD = 8, WGM = 8;
__host__ __device__ __forceinline__ int lds_byte(int r, int c) { const int st = (r >> 4) * 2 + (c >> 5), rr = r & 15, cc = c & 31, ob = rr * 64 + cc * 2; return st * 1024 + (ob ^ (((ob >> 9) & 1) << 5)); }
__host__ __device__ __forceinline__ void stage_rc(int b, int& R, int& C) { const int st = b / 1024, sb = b % 1024, swz = sb ^ (((sb >> 9) & 1) << 5); R = (st >> 1) * 16 + swz / 64; C = (st & 1) * 32 + (swz % 64) / 2; }
__host__ __device__ __forceinline__ int perm32(int rho) { const int n = rho >> 4, i = rho & 15; return 8 * (i >> 2) + 4 * n + (i & 3); }
struct Unit { int pm, pn; };
struct Gemm { const bf16_t* A; const bf16_t* Bt; int M, N, K, lda, ks; ptrdiff_t dA; };
struct StaticOrder {
    int nM, nN, nwg, G, c;
    __host__ __device__ void init(int M, int N, int G_, int c_) { nM = M / BM; nN = N / BM; nwg = nM * nN; G = G_; c = c_; }
    __host__ __device__ bool next(int i, Unit& u) const {
        const long L = (long)i * G + c; if (L >= nwg) return false;
        int wgid = (int)L; { const int q = nwg / NXCD, r = nwg % NXCD, xcd = wgid % NXCD, off = wgid / NXCD; wgid = (xcd < r ? xcd * (q + 1) : r * (q + 1) + (xcd - r) * q) + off; }
        const int nig = WGM * nN, gid = wgid / nig, fm = gid * WGM, gsz = (nM - fm) < WGM ? (nM - fm) : WGM;
        u.pm = fm + ((wgid % nig) % gsz); u.pn = (wgid % nig) / gsz; return true;
    }
    __device__ __forceinline__ void a_ready(const Unit&) const {}
    __device__ __forceinline__ void done(const Unit&) const {}
};
__device__ __forceinline__ unsigned cvt_pk_bf16(float lo, float hi) { unsigned r; asm volatile("v_cvt_pk_bf16_f32 %0, %1, %2" : "=v"(r) : "v"(lo), "v"(hi)); return r; }
struct EpiSwigluF {
    static constexpr bool PERM = true, AFTER_DRAIN = false, HAS_MID = false;
    const float* SQ; bf16_t* H;
    __device__ __forceinline__ void mid(f32x4 (&)[2][2][4][2], const Unit&, int, int) const {}
    __device__ __forceinline__ void operator()(const f32x4 (&acc)[2][2][4][2], const Unit& u, int wr, int wc, int fr, int fq) const {
        const int row0 = u.pm * BM + wr * 64 + fr, hc0 = (u.pn * BM + wc * 32 + 8 * fq) >> 1;
#pragma unroll
        for (int ai = 0; ai < 2; ++ai)
#pragma unroll
            for (int m = 0; m < 4; ++m) { const int r = row0 + ai * HALF + m * 16; const float rs = rstd_of(SQ[r]); bf16_t* rowp = H + (size_t)r * FF + hc0;
#pragma unroll
                for (int bj = 0; bj < 2; ++bj) { const f32x4 g = acc[ai][bj][m][0] * rs, up = acc[ai][bj][m][1] * rs; u32x2 w;
                    w.x = cvt_pk_bf16(siluf(g[0]) * up[0], siluf(g[1]) * up[1]); w.y = cvt_pk_bf16(siluf(g[2]) * up[2], siluf(g[3]) * up[3]);
                    *(u32x2*)(rowp + bj * (HALF / 2)) = w; } }
    }
};
template <bool FIRST, bool MID> struct EpiResidF {
    static constexpr bool PERM = false, AFTER_DRAIN = false, HAS_MID = MID;
    Prm p; float scale; const float* SQrow; const float* SQmid; float* SQacc; bf16_t* XB;
    __device__ __forceinline__ void mid(f32x4 (&acc)[2][2][4][2], const Unit& u, int wr, int fr_) const {
        int fr = fr_; asm volatile("" : "+v"(fr));
#pragma unroll
        for (int ai = 0; ai < 2; ++ai)
#pragma unroll
            for (int m = 0; m < 4; ++m) { const int r = u.pm * BM + ai * HALF + wr * 64 + m * 16 + fr; const float ratio = rstd_of(SQmid[r]) / rstd_of(SQrow[r]);
#pragma unroll
                for (int bj = 0; bj < 2; ++bj)
#pragma unroll
                    for (int n = 0; n < 2; ++n) acc[ai][bj][m][n] = acc[ai][bj][m][n] * ratio;
                asm volatile("" ::: "memory"); }
    }
    __device__ __forceinline__ void operator()(const f32x4 (&acc)[2][2][4][2], const Unit& u, int wr, int wc, int fr, int fq) const {
        const int row0 = u.pm * BM + wr * 64 + fr, col0 = u.pn * BM + wc * 32 + 4 * fq;
#pragma unroll
        for (int ai = 0; ai < 2; ++ai)
#pragma unroll
            for (int m = 0; m < 4; ++m) { const int r = row0 + ai * HALF + m * 16; float* xr = xrow(p, r); const float* src = FIRST ? xsrc_row(p, r) : xr;
                const float sc = scale * (SQrow ? rstd_of(SQrow[r]) : 1.f); float ss = 0.f;
#pragma unroll
                for (int bj = 0; bj < 2; ++bj)
#pragma unroll
                    for (int n = 0; n < 2; ++n) { const int c = col0 + bj * HALF + n * 16; f32x4 xo = (f32x4){0.f, 0.f, 0.f, 0.f}; if (!FIRST || src) xo = *(const f32x4*)(src + c);
                        const f32x4 xn = xo + acc[ai][bj][m][n] * sc; *(f32x4*)(xr + c) = xn; ss += (xn[0] * xn[0] + xn[1] * xn[1]) + (xn[2] * xn[2] + xn[3] * xn[3]);
                        if (XB) { u32x2 w; w.x = cvt_pk_bf16(xn[0], xn[1]); w.y = cvt_pk_bf16(xn[2], xn[3]); *(u32x2*)(XB + (size_t)r * D + c) = w; } }
                ss += __shfl_xor(ss, 16); ss += __shfl_xor(ss, 32);
                if (fq == 0) atomicAdd(SQacc + r, ss); }
    }
};
struct EpiWinF {
    static constexpr bool PERM = true, AFTER_DRAIN = false, HAS_MID = false;
    const float* SQ; bf16_t* U;
    __device__ __forceinline__ void mid(f32x4 (&)[2][2][4][2], const Unit&, int, int) const {}
    __device__ __forceinline__ void operator()(const f32x4 (&acc)[2][2][4][2], const Unit& u, int wr, int wc, int fr, int fq) const {
        const int row0 = u.pm * BM + wr * 64 + fr; const int t = u.pn >> 2; bf16_t* base = U + (size_t)t * ((WS_XM - WS_U) / 2);
        const int col0 = (u.pn & 3) * BM + wc * 32 + 8 * fq;
#pragma unroll
        for (int ai = 0; ai < 2; ++ai)
#pragma unroll
            for (int m = 0; m < 4; ++m) { const int r = row0 + ai * HALF + m * 16; const float rs = rstd_of(SQ[r]); bf16_t* rowp = base + (size_t)r * D + col0;
#pragma unroll
                for (int bj = 0; bj < 2; ++bj) { const f32x4 v0 = acc[ai][bj][m][0] * rs, v1 = acc[ai][bj][m][1] * rs; u32x4 w;
                    w.x = cvt_pk_bf16(v0[0], v0[1]); w.y = cvt_pk_bf16(v0[2], v0[3]); w.z = cvt_pk_bf16(v1[0], v1[1]); w.w = cvt_pk_bf16(v1[2], v1[3]);
                    *(u32x4*)(rowp + bj * HALF) = w; } }
    }
};
struct EpiGluF {
    static constexpr bool PERM = true, AFTER_DRAIN = false, HAS_MID = false;
    const bf16_t* G; const float* bias; bf16_t* Y5; float* SQ5;
    __device__ __forceinline__ void mid(f32x4 (&)[2][2][4][2], const Unit&, int, int) const {}
    __device__ __forceinline__ void operator()(const f32x4 (&acc)[2][2][4][2], const Unit& u, int wr, int wc, int fr, int fq) const {
        const int row0 = u.pm * BM + wr * 64 + fr, col0 = u.pn * BM + wc * 32 + 8 * fq;
        f32x4 bv[2][2];
#pragma unroll
        for (int bj = 0; bj < 2; ++bj)
#pragma unroll
            for (int n = 0; n < 2; ++n) bv[bj][n] = *(const f32x4*)(bias + col0 + bj * HALF + 4 * n);
#pragma unroll
        for (int ai = 0; ai < 2; ++ai)
#pragma unroll
            for (int m = 0; m < 4; ++m) { const int r = row0 + ai * HALF + m * 16; float ss = 0.f;
#pragma unroll
                for (int bj = 0; bj < 2; ++bj) { const size_t off = (size_t)r * D + col0 + bj * HALF; const u32x4 gw = *(const u32x4*)(G + off); float y[8];
#pragma unroll
                    for (int n = 0; n < 2; ++n)
#pragma unroll
                        for (int e = 0; e < 4; ++e) { const unsigned wd = n == 0 ? (e < 2 ? gw.x : gw.y) : (e < 2 ? gw.z : gw.w); const float g = __uint_as_float((e & 1) ? (wd & 0xffff0000u) : (wd << 16));
                            const float v = g * sigmf(acc[ai][bj][m][n][e] + bv[bj][n][e]); y[4 * n + e] = v; ss += v * v; }
                    u32x4 w; w.x = cvt_pk_bf16(y[0], y[1]); w.y = cvt_pk_bf16(y[2], y[3]); w.z = cvt_pk_bf16(y[4], y[5]); w.w = cvt_pk_bf16(y[6], y[7]);
                    *(u32x4*)(Y5 + off) = w; }
                ss += __shfl_xor(ss, 16); ss += __shfl_xor(ss, 32);
                if (fq == 0) atomicAdd(SQ5 + r, ss); }
    }
};
template <class Epi, class Sched, bool ALIGN_EPI = false, bool SP2 = false>
__device__ __forceinline__ void gemm_phase(PG8_LAS unsigned char* lds, const Gemm g, const Sched& S, const Epi& E) {
    const int tid = threadIdx.x, wid = __builtin_amdgcn_readfirstlane(tid >> 6), lane = tid & 63, wr = wid >> 2, wc = wid & 3, fr = lane & 15, fq = lane >> 4;
    const int K = g.K, nt = K / BK;
    unsigned voffA[2], voffB[2];
#pragma unroll
    for (int i = 0; i < 2; ++i) { int R, C; stage_rc(tid * 16 + i * 8192, R, C); const int Rb = Epi::PERM ? ((R & ~31) + perm32(R & 31)) : R;
        voffA[i] = (unsigned)(R * g.lda + C) * 2u; voffB[i] = (unsigned)(Rb * K + C) * 2u; }
    const size_t kstep = (size_t)(BK * 2);
    const size_t hstepA = (size_t)HALF * g.lda * 2, hstepB = (size_t)HALF * K * 2;
    const size_t tstepA = 2 * hstepA, tstepB = 2 * hstepB;
    const unsigned ldsw = (unsigned)wid * 1024u;
    const int aoff = lds_byte(wr * 64 + fr, fq * 8), boff = lds_byte(wc * 32 + fr, fq * 8);
#define PG8_SA(b, h) (((b) * 2 + (h)) * HTB)
#define PG8_SB(b, h) ((4 + (b) * 2 + (h)) * HTB)
#define PG8_STAGE(bufoff, gbase, voff) do { _Pragma("unroll") for (int _i = 0; _i < 2; ++_i) \
        __builtin_amdgcn_global_load_lds((const unsigned*)((const char*)(gbase) + (voff)[_i]), (PG8_LAS unsigned*)(lds + (bufoff) + ldsw + _i * 8192), 16, 0, 0); } while (0)
#define PG8_LDA(dst, b, h) do { _Pragma("unroll") for (int m = 0; m < 4; ++m) _Pragma("unroll") for (int k = 0; k < 2; ++k) dst[m][k] = *(const PG8_LAS bf16x8*)(lds + PG8_SA(b, h) + aoff + m * 2048 + k * 1024); } while (0)
#define PG8_LDB(dst, b, h) do { _Pragma("unroll") for (int n = 0; n < 2; ++n) _Pragma("unroll") for (int k = 0; k < 2; ++k) dst[n][k] = *(const PG8_LAS bf16x8*)(lds + PG8_SB(b, h) + boff + n * 2048 + k * 1024); } while (0)
#define PG8_MMA(ai, bj, At, Bt) do { __builtin_amdgcn_s_setprio(1); _Pragma("unroll") for (int m = 0; m < 4; ++m) _Pragma("unroll") for (int n = 0; n < 2; ++n) _Pragma("unroll") for (int k = 0; k < 2; ++k) \
        acc[ai][bj][m][n] = __builtin_amdgcn_mfma_f32_16x16x32_bf16(Bt[n][k], At[m][k], acc[ai][bj][m][n], 0, 0, 0); __builtin_amdgcn_s_setprio(0); } while (0)
#define PG8_WAIT_V(n) asm volatile("s_waitcnt vmcnt(" #n ")" ::: "memory")
#define PG8_WAIT_L(n) asm volatile("s_waitcnt lgkmcnt(" #n ")" ::: "memory")
#define PG8_BAR __builtin_amdgcn_s_barrier()
#define PG8_SCHED __builtin_amdgcn_sched_barrier(0)
    Unit cur, nxt; int ui = 0;
    if (!S.next(0, cur)) return;
    f32x4 acc[2][2][4][2];
#pragma unroll
    for (int a = 0; a < 2; ++a)
#pragma unroll
        for (int b = 0; b < 2; ++b)
#pragma unroll
            for (int m = 0; m < 4; ++m)
#pragma unroll
                for (int n = 0; n < 2; ++n) acc[a][b][m][n] = (f32x4){0.f, 0.f, 0.f, 0.f};
    bf16x8 At[4][2], B0[2][2], B1[2][2];
    const char* cA = (const char*)g.A + (size_t)cur.pm * tstepA; const char* cB = (const char*)g.Bt + (size_t)cur.pn * tstepB;
    S.a_ready(cur);
    if constexpr (SP2) {
        PG8_STAGE(PG8_SB(0, 0), cB, voffB); PG8_STAGE(PG8_SB(0, 1), cB + hstepB, voffB); PG8_STAGE(PG8_SA(0, 0), cA, voffA); PG8_STAGE(PG8_SA(0, 1), cA + hstepA, voffA);
        if (wr == 1) PG8_BAR;
        PG8_WAIT_V(2); PG8_BAR;
        PG8_STAGE(PG8_SB(1, 0), cB + kstep, voffB); PG8_STAGE(PG8_SA(1, 0), cA + kstep, voffA); PG8_STAGE(PG8_SB(1, 1), cB + hstepB + kstep, voffB);
        PG8_WAIT_V(6); PG8_BAR;
    } else {
        PG8_STAGE(PG8_SB(0, 0), cB, voffB); PG8_STAGE(PG8_SA(0, 0), cA, voffA); PG8_STAGE(PG8_SB(0, 1), cB + hstepB, voffB); PG8_STAGE(PG8_SA(0, 1), cA + hstepA, voffA);
        if (wr == 1) PG8_BAR;
        PG8_WAIT_V(4); PG8_BAR;
        PG8_STAGE(PG8_SB(1, 0), cB + kstep, voffB); PG8_STAGE(PG8_SA(1, 0), cA + kstep, voffA); PG8_STAGE(PG8_SB(1, 1), cB + hstepB + kstep, voffB);
        PG8_WAIT_V(6); PG8_BAR;
    }
    for (;;) {
        const bool has_next = S.next(ui + 1, nxt);
        const char* nA = has_next ? (const char*)g.A + (size_t)nxt.pm * tstepA : cA; const char* nB = has_next ? (const char*)g.Bt + (size_t)nxt.pn * tstepB : cB;
        for (int t = 0; t < nt; t += 2) {
            const bool last = (t == nt - 2);
            if constexpr (Epi::HAS_MID) { if (t == g.ks) E.mid(acc, cur, wr, fr); }
            const char* a1 = cA + (size_t)(t + 1) * kstep + ((t + 1) >= g.ks ? g.dA : (ptrdiff_t)0);
            const char* a2 = last ? nA : cA + (size_t)(t + 2) * kstep + ((t + 2) >= g.ks ? g.dA : (ptrdiff_t)0); const char* b2 = last ? nB : cB + (size_t)(t + 2) * kstep;
            const char* a3 = last ? nA + kstep : cA + (size_t)(t + 3) * kstep + ((t + 3) >= g.ks ? g.dA : (ptrdiff_t)0); const char* b3 = b2 + kstep;
            if (last && has_next) S.a_ready(nxt);
            if constexpr (SP2) {
            PG8_LDB(B0, 0, 0); PG8_LDB(B1, 0, 1); PG8_SCHED; PG8_LDA(At, 0, 0); PG8_STAGE(PG8_SA(1, 1), a1 + hstepA, voffA);
            PG8_WAIT_V(8); PG8_WAIT_L(0); PG8_BAR; PG8_MMA(0, 0, At, B0); PG8_MMA(0, 1, At, B1); PG8_BAR; PG8_SCHED;
            PG8_LDA(At, 0, 1); PG8_STAGE(PG8_SB(0, 0), b2, voffB); PG8_STAGE(PG8_SB(0, 1), b2 + hstepB, voffB); PG8_STAGE(PG8_SA(0, 0), a2, voffA);
            PG8_WAIT_V(8); PG8_WAIT_L(0); PG8_BAR; PG8_MMA(1, 0, At, B0); PG8_MMA(1, 1, At, B1); PG8_BAR; PG8_SCHED;
            PG8_LDB(B0, 1, 0); PG8_LDB(B1, 1, 1); PG8_SCHED; PG8_LDA(At, 1, 0); PG8_STAGE(PG8_SA(0, 1), a2 + hstepA, voffA);
            PG8_WAIT_V(8); PG8_WAIT_L(0); PG8_BAR; PG8_MMA(0, 0, At, B0); PG8_MMA(0, 1, At, B1); PG8_BAR; PG8_SCHED;
            PG8_LDA(At, 1, 1); PG8_STAGE(PG8_SB(1, 0), b3, voffB); PG8_STAGE(PG8_SB(1, 1), b3 + hstepB, voffB); PG8_STAGE(PG8_SA(1, 0), a3, voffA);
            PG8_WAIT_V(8); PG8_WAIT_L(0); PG8_BAR; PG8_MMA(1, 0, At, B0); PG8_MMA(1, 1, At, B1); PG8_BAR; PG8_SCHED;
            } else {
            PG8_LDB(B0, 0, 0); PG8_SCHED; PG8_LDA(At, 0, 0); PG8_STAGE(PG8_SA(1, 1), a1 + hstepA, voffA);
            PG8_WAIT_L(8); PG8_BAR; PG8_WAIT_L(0); PG8_MMA(0, 0, At, B0); PG8_BAR; PG8_SCHED;
            PG8_LDB(B1, 0, 1); PG8_STAGE(PG8_SB(0, 0), b2, voffB);
            PG8_BAR; PG8_WAIT_L(0); PG8_MMA(0, 1, At, B1); PG8_BAR;
            PG8_LDA(At, 0, 1); PG8_STAGE(PG8_SA(0, 0), a2, voffA);
            PG8_BAR; PG8_WAIT_L(0); PG8_MMA(1, 0, At, B0); PG8_BAR; PG8_SCHED;
            PG8_STAGE(PG8_SB(0, 1), b2 + hstepB, voffB);
            PG8_WAIT_V(6); PG8_BAR; PG8_MMA(1, 1, At, B1); PG8_BAR;
            PG8_LDB(B0, 1, 0); PG8_SCHED; PG8_LDA(At, 1, 0); PG8_STAGE(PG8_SA(0, 1), a2 + hstepA, voffA);
            PG8_WAIT_L(8); PG8_BAR; PG8_WAIT_L(0); PG8_MMA(0, 0, At, B0); PG8_BAR; PG8_SCHED;
            PG8_LDB(B1, 1, 1); PG8_STAGE(PG8_SB(1, 0), b3, voffB);
            PG8_BAR; PG8_WAIT_L(0); PG8_MMA(0, 1, At, B1); PG8_BAR;
            PG8_LDA(At, 1, 1); PG8_STAGE(PG8_SA(1, 0), a3, voffA);
            PG8_BAR; PG8_WAIT_L(0); PG8_MMA(1, 0, At, B0); PG8_BAR; PG8_SCHED;
            PG8_STAGE(PG8_SB(1, 1), b3 + hstepB, voffB);
            PG8_WAIT_V(6); PG8_BAR; PG8_MMA(1, 1, At, B1); PG8_BAR;
            }
        }
        if constexpr (ALIGN_EPI) { if (wr == 0) PG8_BAR; }
        if constexpr (!Epi::AFTER_DRAIN) { E(acc, cur, wr, wc, fr, fq); S.done(cur); }
        if (!has_next) break;
#pragma unroll
        for (int a = 0; a < 2; ++a)
#pragma unroll
            for (int b = 0; b < 2; ++b)
#pragma unroll
                for (int m = 0; m < 4; ++m)
#pragma unroll
                    for (int n = 0; n < 2; ++n) acc[a][b][m][n] = (f32x4){0.f, 0.f, 0.f, 0.f};
        cur = nxt; cA = nA; cB = nB; ++ui;
        if constexpr (ALIGN_EPI) { if (wr == 1) PG8_BAR; }
    }
    PG8_WAIT_V(0);
    if constexpr (!ALIGN_EPI) { if (wr == 0) PG8_BAR; }
    PG8_BAR;
    if constexpr (Epi::AFTER_DRAIN) { E.fused(acc, cur, wr, wc, fr, fq, lds, wid, lane); S.done(cur); }
#undef PG8_SA
#undef PG8_SB
#undef PG8_STAGE
#undef PG8_LDA
#undef PG8_LDB
#undef PG8_MMA
#undef PG8_WAIT_V
#undef PG8_WAIT_L
#undef PG8_BAR
#undef PG8_SCHED
}}
constexpr int NWAVES = 8;
constexpr int RING_OFF = 0;
constexpr int LDS_BYTES = 163840;
constexpr int LDSCTL_OFF = LDS_BYTES - 512, MISC_OFF = LDSCTL_OFF + 320;
constexpr int CW_TMO = 0, CW_CODE = 1, CW_BAR = 4096;
#define GAS __attribute__((address_space(1)))
#define LAS __attribute__((address_space(3)))
typedef unsigned v4u __attribute__((ext_vector_type(4)));
typedef float f32x4 __attribute__((ext_vector_type(4)));
typedef short bf16x8 __attribute__((ext_vector_type(8)));
typedef GAS unsigned gu32;
#define RLX_AGENT __ATOMIC_RELAXED, __HIP_MEMORY_SCOPE_AGENT
#define LDS_WAIT() asm volatile("s_waitcnt lgkmcnt(0)" ::: "memory")
#define VM_WAIT() asm volatile("s_waitcnt vmcnt(0)" ::: "memory")
#define XB_TMO      128
#define XB_XCNT(j)  (256  + 64 * (j))
#define XB_XSUB(j)  (1280 + 64 * (j))
#define XB_XGEN(j)  (2304 + 64 * (j))
#define XB_TOP      3328
#define XB_TOPGEN   3392
#define XCD_BAR_WORDS 3456
#define XB_SPIN_CAP (1u << 18)
__device__ __forceinline__ unsigned xb_ld(unsigned* p)              { return __hip_atomic_load(p, __ATOMIC_RELAXED, __HIP_MEMORY_SCOPE_AGENT); }
__device__ __forceinline__ unsigned xb_add(unsigned* p, unsigned v) { return __hip_atomic_fetch_add(p, v, __ATOMIC_RELAXED, __HIP_MEMORY_SCOPE_AGENT); }
__device__ __forceinline__ unsigned xb_xcc_id() { return (unsigned)__builtin_amdgcn_s_getreg((3 << 11) | 20) & 0xFu; }
#define XB_SPIN(cond, bar) do { unsigned _sp = 0; while (cond) { __builtin_amdgcn_s_sleep(1); \
    if ((++_sp & 255u) == 0u) { if (xb_ld(&(bar)[XB_TMO])) break; if (_sp > XB_SPIN_CAP) { atomicAdd(&(bar)[XB_TMO], 1u); break; } } } } while (0)
struct XcdBarrier { unsigned* bar; unsigned x; volatile LAS unsigned* st; };
__device__ __forceinline__ XcdBarrier xcd_barrier_post(unsigned* bar, volatile LAS unsigned* st) {
    XcdBarrier b; b.bar = bar; b.x = xb_xcc_id(); b.st = st;
    if (threadIdx.x == 0) (void)xb_add(&bar[XB_XCNT(b.x)], 1u);
    return b;
}
__device__ __forceinline__ void xcd_barrier_complete(unsigned* bar, unsigned x, unsigned& nloc, unsigned& nx) {
    const unsigned G = gridDim.x * gridDim.y * gridDim.z;
    unsigned sum, cnt, mine, sp = 0u;
    for (;;) {
        sum = 0u; cnt = 0u; mine = 0u;
#pragma unroll
        for (unsigned j = 0; j < 16; ++j) { const unsigned c = xb_ld(&bar[XB_XCNT(j)]); sum += c; cnt += (c > 0u) ? 1u : 0u; mine = (j == x) ? c : mine; }
        if (sum == G) break;
        __builtin_amdgcn_s_sleep(1);
        if ((++sp & 255u) == 0u) { if (xb_ld(&bar[XB_TMO])) break; if (sp > XB_SPIN_CAP) { atomicAdd(&bar[XB_TMO], 1u); break; } }
    }
    nloc = mine > 0u ? mine : 1u; nx = cnt > 0u ? cnt : 1u;
}
__device__ __forceinline__ void xcd_barrier(const XcdBarrier& b) {
    asm volatile("s_waitcnt vmcnt(0)" ::: "memory");
    __syncthreads();
    if (threadIdx.x == 0) {
        unsigned* bar = b.bar;
        __builtin_amdgcn_s_waitcnt(0);
        unsigned nloc = b.st[0], nx = b.st[1];
        if (nloc == 0u) { xcd_barrier_complete(bar, b.x, nloc, nx); b.st[0] = nloc; b.st[1] = nx; }
        const unsigned old = xb_add(&bar[XB_XSUB(b.x)], 1u);
        const unsigned gen = old / nloc;
        if (old + 1u == (gen + 1u) * nloc) {
            __builtin_amdgcn_fence(__ATOMIC_RELEASE, "agent");
            asm volatile("s_waitcnt vmcnt(0)" ::: "memory");
            const unsigned og = xb_add(&bar[XB_TOP], 1u);
            const unsigned tg = og / nx;
            if (og + 1u == (tg + 1u) * nx) xb_add(&bar[XB_TOPGEN], 1u);
            else XB_SPIN(xb_ld(&bar[XB_TOPGEN]) == tg, bar);
            __builtin_amdgcn_fence(__ATOMIC_ACQUIRE, "agent");
            xb_add(&bar[XB_XGEN(b.x)], 1u);
            asm volatile("s_waitcnt vmcnt(0)" ::: "memory");
        } else {
            XB_SPIN(xb_ld(&bar[XB_XGEN(b.x)]) == gen, bar);
            __builtin_amdgcn_fence(__ATOMIC_ACQUIRE, "agent");
            asm volatile("s_waitcnt vmcnt(0)" ::: "memory");
        }
    }
    __syncthreads();
}

__device__ __forceinline__ void p0_transpose_item(const float* W, int K, int N, bf16* WT, int ldt, int rowmode, int hasScale, const float* scaleA, const float* scaleB  , LAS float* scr, int item, int lane) {
    const int nblk = N / 32, kb = item / nblk, nb = item % nblk, k0 = 64 * kb, n0 = 32 * nb;
#pragma unroll 8
    for (int i = 0; i < 32; ++i) { const int kk = 2 * i + (lane >> 5), k = k0 + kk; float s = 1.f; if (hasScale) s = (k < D) ? scaleA[k] : scaleB[k];
        scr[kk * 33 + (lane & 31)] = W[(size_t)k * N + n0 + (lane & 31)] * s; }
    LDS_WAIT(); asm volatile("" ::: "memory");
    const int c = lane & 7;
#pragma unroll
    for (int j = 0; j < 4; ++j) { const int n = (lane >> 3) + 8 * j; const LAS float* s = scr + (8 * c) * 33 + n; const int ng = n0 + n;
        const int dr = rowmode == 0 ? ng : ((ng >> 2) * 8 + (ng & 3) + (rowmode == 2 ? 4 : 0));
        v4u o; o.x = pk2(s[0 * 33], s[1 * 33]); o.y = pk2(s[2 * 33], s[3 * 33]); o.z = pk2(s[4 * 33], s[5 * 33]); o.w = pk2(s[6 * 33], s[7 * 33]);
        *(GAS v4u*)(WT + (size_t)dr * ldt + k0 + 8 * c) = o; }
    LDS_WAIT(); asm volatile("" ::: "memory");
}
__device__ __forceinline__ void p0_row(const Prm& p, int r, int lane) {
    const float* src = xsrc_row(p, r); bf16* XB = (bf16*)(p.ws + WS_XB); float* SQ0 = (float*)(p.ws + WS_SQ0);
    f32x4 v[4]; float s = 0.f;
#pragma unroll
    for (int j = 0; j < 4; ++j) { v[j] = src ? ((const GAS f32x4*)src)[lane + 64 * j] : (f32x4){0.f, 0.f, 0.f, 0.f}; s += (v[j].x * v[j].x + v[j].y * v[j].y) + (v[j].z * v[j].z + v[j].w * v[j].w); }
    s = wave_sum(s);
    GAS unsigned long long* o8 = (GAS unsigned long long*)(XB + (size_t)r * D) + lane;
#pragma unroll
    for (int j = 0; j < 4; ++j) o8[64 * j] = (unsigned long long)pk2(v[j].x, v[j].y) | ((unsigned long long)pk2(v[j].z, v[j].w) << 32);
    if (lane == 0) SQ0[r] = s;
}
__device__ __forceinline__ void p0_s5tables(const Prm& p, int i) {
    const int g = i / NP5, pp = i % NP5;
    const double lre = p.in[I_LRE][i], lim = p.in[I_LIM][i], dt = exp((double)p.in[I_LOGDT][g]);
    const double er = exp(lre * dt), lbr = er * cos(lim * dt), lbi = er * sin(lim * dt);
    const double e64 = exp(64.0 * lre * dt), l64r = e64 * cos(64.0 * lim * dt), l64i = e64 * sin(64.0 * lim * dt);
    float* LAMB = (float*)(p.ws + WS_LAMB); float* LAM64 = (float*)(p.ws + WS_LAM64);
    LAMB[2 * i] = (float)lbr; LAMB[2 * i + 1] = (float)lbi; LAM64[2 * i] = (float)l64r; LAM64[2 * i + 1] = (float)l64i;
    const double nr = lbr - 1.0, ni = lbi, dd = lre * lre + lim * lim;
    const double cr = (nr * lre + ni * lim) / dd, ci = (ni * lre - nr * lim) / dd;
    float* BBF = (float*)(p.ws + WS_BBF); bf16* BB = (bf16*)(p.ws + WS_BB); bf16* CMB = (bf16*)(p.ws + WS_CMB);
    for (int h = 0; h < NH5; ++h) {
        const double br = p.in[I_BRE][(size_t)i * NH5 + h], bi = p.in[I_BIM][(size_t)i * NH5 + h];
        const float xr = (float)(cr * br - ci * bi), xi = (float)(cr * bi + ci * br);
        BBF[((size_t)i * NH5 + h) * 2] = xr; BBF[((size_t)i * NH5 + h) * 2 + 1] = xi;
        BB[((size_t)g * 128 + pp) * 16 + h] = (bf16)f2bf(xr); BB[((size_t)g * 128 + 64 + pp) * 16 + h] = (bf16)f2bf(xi);
        const float c_re = p.in[I_CRE][((size_t)g * NH5 + h) * NP5 + pp], c_im = p.in[I_CIM][((size_t)g * NH5 + h) * NP5 + pp];
        CMB[((size_t)g * 16 + h) * 128 + pp] = (bf16)f2bf(c_re); CMB[((size_t)g * 16 + h) * 128 + 64 + pp] = (bf16)f2bf(-c_im);
    }
}
__device__ __forceinline__ void p0_prologue(const Prm& p, LAS unsigned char* lds, int vcu, int G, int wave, int lane) {
    LAS float* scr = (LAS float*)(lds + RING_OFF + wave * 16384);
    const int gw = vcu * NWAVES + wave, NGW = G * NWAVES;
    unsigned char* ws = p.ws;
    constexpr int I_GU = (D / 64) * (FF / 32), I_DN = (FF / 64) * (D / 32), I_IN = (D / 64) * (NPROJ / 32), I_GL = (D / 64) * (D / 32), I_WO = (2 * D / 64) * (D / 32);
    constexpr int NITEMS = 4 * I_GU + 2 * I_DN + I_IN + I_GL + I_WO;
    const float* ones = nullptr;
    for (int it = gw; it < NITEMS; it += NGW) {
        int r = it, mat = 0;
        if (r >= I_GU) { r -= I_GU; mat = 1; if (r >= I_GU) { r -= I_GU; mat = 2; if (r >= I_DN) { r -= I_DN; mat = 3; if (r >= I_IN) { r -= I_IN; mat = 4; if (r >= I_GL) { r -= I_GL; mat = 5;
            if (r >= I_WO) { r -= I_WO; mat = 6; if (r >= I_GU) { r -= I_GU; mat = 7; if (r >= I_GU) { r -= I_GU; mat = 8; } } } } } } } }
        const float* W; int K, N, ldt, rowmode, hasScale; size_t wsoff; const float* sA; const float* sB;
        switch (mat) {
            case 0: W = p.in[I_G1]; K = D; N = FF; wsoff = WS_W1GU; ldt = D; rowmode = 1; hasScale = 1; sA = p.in[I_NORM1]; sB = p.in[I_NORM1]; break;
            case 1: W = p.in[I_U1]; K = D; N = FF; wsoff = WS_W1GU; ldt = D; rowmode = 2; hasScale = 1; sA = p.in[I_NORM1]; sB = p.in[I_NORM1]; break;
            case 2: W = p.in[I_D1]; K = FF; N = D; wsoff = WS_W1D; ldt = FF; rowmode = 0; hasScale = 0; sA = p.in[I_NORM1]; sB = p.in[I_NORM1]; break;
            case 3: W = p.in[I_WIN]; K = D; N = NPROJ; wsoff = WS_WIN; ldt = D; rowmode = 0; hasScale = 1; sA = p.in[I_NORMMIX]; sB = p.in[I_NORMMIX]; break;
            case 4: W = p.in[I_GLUW]; K = D; N = D; wsoff = WS_WGLU; ldt = D; rowmode = 0; hasScale = 0; sA = p.in[I_NORM1]; sB = p.in[I_NORM1]; break;
            case 5: W = p.in[I_WOUT]; K = 2 * D; N = D; wsoff = WS_WOUT; ldt = 2 * D; rowmode = 0; hasScale = 1; sA = p.in[I_ONS5]; sB = p.in[I_ONML] - D; break;
            case 6: W = p.in[I_G2]; K = D; N = FF; wsoff = WS_W2GU; ldt = D; rowmode = 1; hasScale = 1; sA = p.in[I_NORM2]; sB = p.in[I_NORM2]; break;
            case 7: W = p.in[I_U2]; K = D; N = FF; wsoff = WS_W2GU; ldt = D; rowmode = 2; hasScale = 1; sA = p.in[I_NORM2]; sB = p.in[I_NORM2]; break;
            default: W = p.in[I_D2]; K = FF; N = D; wsoff = WS_W2D; ldt = FF; rowmode = 0; hasScale = 0; sA = p.in[I_NORM1]; sB = p.in[I_NORM1]; break;
        }
        (void)ones;
        p0_transpose_item(W, K, N, (bf16*)(ws + wsoff), ldt, rowmode, hasScale, sA, sB, scr, r, lane);
    }
    for (int m = gw; m < MR; m += NGW) p0_row(p, m, lane);
    const int gt = gw * 64 + lane, NGT = NGW * 64;
    for (int i = gt; i < NG5 * NP5; i += NGT) p0_s5tables(p, i);
    for (int i = gt; i < 16 * 3072; i += NGT) { const int row = i / 3072, c = i % 3072; float v = 0.f;
        if (row < 4) v = p.in[I_IGW][(size_t)c * 4 + row]; else if (row < 8) v = p.in[I_FGW][(size_t)c * 4 + row - 4];
        ((bf16*)(ws + WS_GWT))[i] = (bf16)f2bf(v); }
}
__device__ __forceinline__ void p_final(const Prm& p, int vcu, int G, int wave, int lane) {
    const int gw = vcu * NWAVES + wave, NGW = G * NWAVES; const float* SQ3 = (const float*)(p.ws + WS_SQ3); const GAS f32x4* nf = (const GAS f32x4*)p.in[I_NORMF];
    for (int r = gw; r < MR; r += NGW) {
        if (r < SROW0) { const int tp = r >= SLOT ? r - SLOT : r; if (tp < 256) continue; }
        GAS f32x4* xr = (GAS f32x4*)xrow(p, r); const float rs = rstd_of(SQ3[r]);
#pragma unroll
        for (int j = 0; j < 4; ++j) { const f32x4 v = xr[lane + 64 * j] * rs * nf[lane + 64 * j]; xr[lane + 64 * j] = v; }
    }
}
typedef float f32x16 __attribute__((ext_vector_type(16)));
typedef unsigned u32x2v __attribute__((ext_vector_type(2)));
constexpr int S5_BU_STRIDE = 132, S5_S_STRIDE = 136;
constexpr int S5_WAVE_LDS = 16 * S5_BU_STRIDE * 4 + 16 * S5_S_STRIDE * 2;
#define WAVE_LDS_SYNC() do { asm volatile("s_waitcnt lgkmcnt(0)" ::: "memory"); __builtin_amdgcn_wave_barrier(); } while (0)
template <bool PASS_C>
__device__ __forceinline__ void s5_wave_unit(const Prm& p, LAS unsigned char* wlds, int ch, int g, int lane) {
    unsigned char* ws = p.ws;
    bf16* U = (bf16*)(ws + WS_U); const bf16* BB = (const bf16*)(ws + WS_BB); const bf16* CMB = (const bf16*)(ws + WS_CMB);
    float* DS = (float*)(ws + WS_DS); const float* LAMB = (const float*)(ws + WS_LAMB);
    LAS float* BU = (LAS float*)wlds; LAS bf16* SS = (LAS bf16*)(wlds + 16 * S5_BU_STRIDE * 4);
    const int r0 = ch * 64, l31 = lane & 31, lh = lane >> 5, l15 = lane & 15, lq = lane >> 4;
    const bool sample = r0 >= SROW0;
    const float lr = LAMB[2 * (g * 64 + lane)], li = LAMB[2 * (g * 64 + lane) + 1];
    bf16x8 bfr[4], cfr[4];
#pragma unroll
    for (int ct = 0; ct < 4; ++ct) bfr[ct] = *(const bf16x8*)(BB + ((size_t)(g * 128 + 32 * ct + l31) * 16 + 8 * lh));
    if (PASS_C) {
#pragma unroll
        for (int ks = 0; ks < 4; ++ks) cfr[ks] = *(const bf16x8*)(CMB + ((size_t)(g * 16 + l15) * 128 + 32 * ks + 8 * lq));
    }
    f32x4 dsk = (f32x4){0.f, 0.f, 0.f, 0.f};
    if (PASS_C) dsk = *(const f32x4*)(p.in[I_S5D] + g * 16 + 4 * lq);
    float sr = 0.f, si = 0.f;
#pragma unroll 1
    for (int rt = 0; rt < 2; ++rt) {
        if (rt == 0 || sample) {
            if (PASS_C) {
                if (sample) { const int j = (r0 - SROW0) / TS + rt; sr = p.in[I_S5RE][((size_t)j * 64 + g) * 64 + lane]; si = p.in[I_S5IM][((size_t)j * 64 + g) * 64 + lane]; }
                else { const float2 v = *(const float2*)(DS + ((size_t)ch * 4096 + g * 64 + lane) * 2); sr = v.x; si = v.y; }
            } else { sr = 0.f; si = 0.f; }
        }
        const int rbase = r0 + 32 * rt;
        const bf16x8 afr = *(const bf16x8*)(U + (size_t)(rbase + l31) * D + g * 16 + 8 * lh);
        f32x16 acc[4];
#pragma unroll
        for (int ct = 0; ct < 4; ++ct) { f32x16 z; for (int i = 0; i < 16; ++i) z[i] = 0.f; acc[ct] = __builtin_amdgcn_mfma_f32_32x32x16_bf16(afr, bfr[ct], z, 0, 0, 0); }
#pragma unroll
        for (int hf = 0; hf < 2; ++hf) {
            WAVE_LDS_SYNC();
#pragma unroll
            for (int ct = 0; ct < 4; ++ct)
#pragma unroll
                for (int i = 0; i < 8; ++i) { const int tl = (i & 3) + 8 * (i >> 2) + 4 * lh; BU[tl * S5_BU_STRIDE + 32 * ct + l31] = acc[ct][8 * hf + i]; }
            WAVE_LDS_SYNC();
#pragma unroll
            for (int tl = 0; tl < 16; ++tl) {
                const float bre = BU[tl * S5_BU_STRIDE + lane], bim = BU[tl * S5_BU_STRIDE + 64 + lane];
                const float nr = lr * sr - li * si + bre, ni = lr * si + li * sr + bim; sr = nr; si = ni;
                if (PASS_C) { SS[tl * S5_S_STRIDE + lane] = (bf16)f2bf(sr); SS[tl * S5_S_STRIDE + 64 + lane] = (bf16)f2bf(si); }
            }
            if (PASS_C) {
                WAVE_LDS_SYNC();
                f32x4 y = (f32x4){0.f, 0.f, 0.f, 0.f};
#pragma unroll
                for (int ks = 0; ks < 4; ++ks) { const bf16x8 sfr = *(const LAS bf16x8*)(SS + l15 * S5_S_STRIDE + 32 * ks + 8 * lq); y = __builtin_amdgcn_mfma_f32_16x16x32_bf16(cfr[ks], sfr, y, 0, 0, 0); }
                bf16* up = U + (size_t)(rbase + 16 * hf + l15) * D + g * 16 + 4 * lq;
                const u32x2v uw = *(const u32x2v*)up;
                const float u0 = __uint_as_float(uw.x << 16), u1 = __uint_as_float(uw.x & 0xffff0000u), u2 = __uint_as_float(uw.y << 16), u3 = __uint_as_float(uw.y & 0xffff0000u);
                u32x2v ow; ow.x = pk2(geluf(y[0] + dsk[0] * u0), geluf(y[1] + dsk[1] * u1)); ow.y = pk2(geluf(y[2] + dsk[2] * u2), geluf(y[3] + dsk[3] * u3));
                *(u32x2v*)up = ow;
            }
        }
        if (rt == 1 || sample) {
            if (!PASS_C) { if (!sample) *(float2*)(DS + ((size_t)ch * 4096 + g * 64 + lane) * 2) = make_float2(sr, si); }
            else {
                if (sample) { const int j = (r0 - SROW0) / TS + rt; p.out[O_SS5R + ((size_t)j * 64 + g) * 64 + lane] = sr; p.out[O_SS5I + ((size_t)j * 64 + g) * 64 + lane] = si; }
                else if ((ch % (SLOT / 64)) == (SLOT / 64) - 1) { const int b = ch / (SLOT / 64); p.out[O_PS5R + ((size_t)b * 64 + g) * 64 + lane] = sr; p.out[O_PS5I + ((size_t)b * 64 + g) * 64 + lane] = si; }
            }
        }
    }
    WAVE_LDS_SYNC();
}
template <bool PASS_C>
__device__ __forceinline__ void s5_phase(const Prm& p, LAS unsigned char* lds, int blk, int nblk, int wave, int lane) {
    const int nch = PASS_C ? NCH64 : (NB * SLOT / 64);
    for (int uidx = blk; uidx < nch * 8; uidx += nblk) { const int ch = uidx >> 3, go = uidx & 7; s5_wave_unit<PASS_C>(p, lds + wave * S5_WAVE_LDS, ch, go * 8 + wave, lane); }
}
__device__ __forceinline__ void s5_scan(const Prm& p, int gtid, int ngt) {
    float2* DS = (float2*)(p.ws + WS_DS); const float2* LAM64 = (const float2*)(p.ws + WS_LAM64);
    constexpr int NC = SLOT / 64;
    for (int i = gtid; i < NB * 4096; i += ngt) {
        const int b = i >> 12, gp = i & 4095; const float2 l = LAM64[gp]; float sr = 0.f, si = 0.f;
        float2* base = DS + (size_t)b * NC * 4096 + gp;
#pragma unroll 1
        for (int c0 = 0; c0 < NC; c0 += 12) {
            float2 v[12];
#pragma unroll
            for (int k = 0; k < 12; ++k) v[k] = base[(size_t)(c0 + k) * 4096];
#pragma unroll
            for (int k = 0; k < 12; ++k) { base[(size_t)(c0 + k) * 4096] = make_float2(sr, si); const float nr = l.x * sr - l.y * si + v[k].x, ni = l.x * si + l.y * sr + v[k].y; sr = nr; si = ni; }
        }
    }
}
typedef unsigned u32x4v __attribute__((ext_vector_type(4)));
__device__ __forceinline__ float bflo(unsigned w) { return __uint_as_float(w << 16); }
__device__ __forceinline__ float bfhi(unsigned w) { return __uint_as_float(w & 0xffff0000u); }
__device__ __forceinline__ void xm4_at(const Prm& p, const bf16* XM, int r, int back, int ch4, float (&o)[4]) {
    bool fromx = true; const float* cs = nullptr;
    if (r >= SROW0) { const int j = (r - SROW0) / TS, t = (r - SROW0) % TS - back; if (t < 0) { fromx = false; cs = p.in[I_MLCONV] + ((size_t)j * 3 + (3 + t)) * D + ch4; } }
    else { const int tp = (r >= SLOT ? r - SLOT : r) - back; if (tp < 0) fromx = false; }
    if (fromx) { const u32x2v w = *(const u32x2v*)(XM + (size_t)(r - back) * D + ch4); o[0] = bflo(w.x); o[1] = bfhi(w.x); o[2] = bflo(w.y); o[3] = bfhi(w.y); }
    else if (cs) { const f32x4 v = *(const f32x4*)cs; o[0] = v[0]; o[1] = v[1]; o[2] = v[2]; o[3] = v[3]; }
    else { o[0] = o[1] = o[2] = o[3] = 0.f; }
}
constexpr int PG_STRIDE = 2056;
constexpr int PG_TILE_BYTES = 70 * PG_STRIDE;
__device__ __forceinline__ void pg_unit(const Prm& p, LAS unsigned char* lds, int rb, int tid, int wave, int lane) {
    unsigned char* ws = p.ws; const bf16* XM = (const bf16*)(ws + WS_XM); bf16* KB = (bf16*)(ws + WS_XB);
    float* IG = (float*)(ws + WS_IG); float* LF = (float*)(ws + WS_LF);
    const int r0 = rb * 64; const bool sample = r0 >= SROW0;
    for (int c = tid; c < 70 * 256; c += NWAVES * 64) {
        const int tr = c >> 8, pc = c & 255; float v[4];
        if (tr < 64) xm4_at(p, XM, r0 + tr, 0, 4 * pc, v);
        else if (tr < 67) xm4_at(p, XM, r0, 67 - tr, 4 * pc, v);
        else { if (sample) xm4_at(p, XM, r0 + 32, 70 - tr, 4 * pc, v); else { v[0] = v[1] = v[2] = v[3] = 0.f; } }
        u32x2v w; w.x = pk2(v[0], v[1]); w.y = pk2(v[2], v[3]);
        *(LAS u32x2v*)(lds + tr * PG_STRIDE + pc * 8) = w;
    }
    __syncthreads();
    const int i = lane; int prow[3];
#pragma unroll
    for (int b = 1; b <= 3; ++b) { const int s0 = (sample && i >= 32) ? 32 : 0; const int j = i - b; prow[b - 1] = (j >= s0) ? j : ((s0 == 0 ? 64 : 67) + (j - s0 + 3)); }
    float ga[8];
#pragma unroll
    for (int h = 0; h < 8; ++h) ga[h] = 0.f;
    const float* cw = p.in[I_CONVW]; const float* cb = p.in[I_CONVB]; const float* wq = p.in[I_WQ]; const float* wk = p.in[I_WK]; const float* wv = p.in[I_WV];
    const float* igw = p.in[I_IGW]; const float* fgw = p.in[I_FGW];
#pragma unroll 1
    for (int bb = 0; bb < 32; ++bb) {
        const int blk = wave * 32 + bb, ch = 4 * blk;
        LAS unsigned char* colp = lds + ch * 2;
        const u32x2v w3 = *(const LAS u32x2v*)(colp + i * PG_STRIDE), w2 = *(const LAS u32x2v*)(colp + prow[0] * PG_STRIDE), w1 = *(const LAS u32x2v*)(colp + prow[1] * PG_STRIDE), w0 = *(const LAS u32x2v*)(colp + prow[2] * PG_STRIDE);
        const float x3[4] = {bflo(w3.x), bfhi(w3.x), bflo(w3.y), bfhi(w3.y)}, x2[4] = {bflo(w2.x), bfhi(w2.x), bflo(w2.y), bfhi(w2.y)};
        const float x1[4] = {bflo(w1.x), bfhi(w1.x), bflo(w1.y), bfhi(w1.y)}, x0[4] = {bflo(w0.x), bfhi(w0.x), bflo(w0.y), bfhi(w0.y)};
        float xc[4];
#pragma unroll
        for (int e = 0; e < 4; ++e) xc[e] = siluf(cb[ch + e] + cw[ch + e] * x0[e] + cw[D + ch + e] * x1[e] + cw[2 * D + ch + e] * x2[e] + cw[3 * D + ch + e] * x3[e]);
        float kk[4];
#pragma unroll
        for (int o = 0; o < 4; ++o) { float q = 0.f, k = 0.f, v = 0.f;
#pragma unroll
            for (int e = 0; e < 4; ++e) { q += xc[e] * wq[(blk * 4 + e) * 4 + o]; k += xc[e] * wk[(blk * 4 + e) * 4 + o]; v += x3[e] * wv[(blk * 4 + e) * 4 + o]; }
            kk[o] = k; const int c = ch + o;
#pragma unroll
            for (int h = 0; h < 4; ++h) { ga[h] += q * igw[c * 4 + h] + k * igw[(1024 + c) * 4 + h] + v * igw[(2048 + c) * 4 + h];
                                          ga[4 + h] += q * fgw[c * 4 + h] + k * fgw[(1024 + c) * 4 + h] + v * fgw[(2048 + c) * 4 + h]; } }
        u32x2v kw; kw.x = pk2(kk[0] * 0.0625f, kk[1] * 0.0625f); kw.y = pk2(kk[2] * 0.0625f, kk[3] * 0.0625f);
        *(LAS u32x2v*)(colp + i * PG_STRIDE) = kw;
    }
    __syncthreads();
    for (int c = tid; c < 64 * 256; c += NWAVES * 64) { const int tr = c >> 8, pc = c & 255; *(u32x2v*)(KB + (size_t)(r0 + tr) * D + 4 * pc) = *(const LAS u32x2v*)(lds + tr * PG_STRIDE + pc * 8); }
    __syncthreads();
    LAS float* red = (LAS float*)lds;
#pragma unroll
    for (int h = 0; h < 8; ++h) red[(wave * 64 + i) * 8 + h] = ga[h];
    __syncthreads();
    { const int row = tid & 63, h = tid >> 6; float s = 0.f;
#pragma unroll
      for (int w = 0; w < 8; ++w) s += red[(w * 64 + row) * 8 + h];
      const int r = r0 + row; const bool pad = row_is_pad(r);
      if (h < 4) IG[(size_t)r * 4 + h] = pad ? -1e30f : s + p.in[I_IGB][h]; else LF[(size_t)r * 4 + h - 4] = pad ? 0.f : logsigf(s + p.in[I_FGB][h - 4]); }
    __syncthreads();
}
__device__ __forceinline__ void convout_items(const Prm& p, int gtid, int ngt) {
    const bf16* XM = (const bf16*)(p.ws + WS_XM);
    for (int i = gtid; i < NB * 3 * D + NSTR * 3 * D; i += ngt) {
        if (i < NB * 3 * D) { const int b = i / (3 * D), j = (i / D) % 3, c = i % D; p.out[O_PCONV + i] = bf2f(XM[(size_t)(b * SLOT + SLOT - 3 + j) * D + c]); }
        else { const int k = i - NB * 3 * D; const int s = k / (3 * D), j = (k / D) % 3, c = k % D; p.out[O_SCONV + k] = bf2f(XM[(size_t)(SROW0 + s * TS + TS - 3 + j) * D + c]); }
    }
}
constexpr int KT_STRIDE = 72;
constexpr int PM_KT_OFF = 0, PM_VT_OFF = 256 * KT_STRIDE * 2  , PM_W_OFF = PM_VT_OFF + 128 * KT_STRIDE * 2  , PM_RED_OFF = PM_W_OFF + 1024;
__device__ __forceinline__ int crow32(int reg, int lh) { return (reg & 3) + 8 * (reg >> 2) + 4 * lh; }
__device__ __forceinline__ void seg_rows(int seg, int& row0, int& L) { if (seg < NB * (SLOT / 256)) { row0 = seg * 256; L = 256; } else { row0 = SROW0 + (seg - NB * (SLOT / 256)) * TS; L = TS; } }
__device__ __forceinline__ void pm_unit(const Prm& p, LAS unsigned char* lds, int unit, int tid, int wave, int lane) {
    unsigned char* ws = p.ws; const bf16* XM = (const bf16*)(ws + WS_XM); const bf16* KB = (const bf16*)(ws + WS_XB);
    const float* IG = (const float*)(ws + WS_IG); const float* LF = (const float*)(ws + WS_LF);
    float* BC = (float*)(ws + WS_BC); float* AA = (float*)(ws + WS_AA); float* AM = (float*)(ws + WS_AM);
    bf16* CS = (bf16*)(ws + WS_CS); float* NS = (float*)(ws + WS_NS); float* SEGS = (float*)(ws + WS_SEGS);
    const int vh = unit & 1, hd = (unit >> 1) & 3, seg = unit >> 3; int row0, L; seg_rows(seg, row0, L);
    LAS bf16* Kt = (LAS bf16*)(lds + PM_KT_OFF); LAS bf16* Vt = (LAS bf16*)(lds + PM_VT_OFF); LAS float* wL = (LAS float*)(lds + PM_W_OFF); LAS float* red = (LAS float*)(lds + PM_RED_OFF);
    if (wave == 0) {
        const int cnt = L / 64 > 0 ? L / 64 : 1; const bool act = (L >= 64) || lane < L;
        float lf[4], ig[4], bc[4], av[4], am[4]; float ls = 0.f;
#pragma unroll
        for (int k = 0; k < 4; ++k) { const bool on = act && k < cnt; const int r = row0 + cnt * lane + k; lf[k] = on ? LF[(size_t)r * 4 + hd] : 0.f; ig[k] = on ? IG[(size_t)r * 4 + hd] : -1e30f; ls += lf[k]; bc[k] = ls; }
        float pre = ls;
#pragma unroll
        for (int o = 1; o < 64; o <<= 1) { const float t = __shfl_up(pre, o); if (lane >= o) pre += t; }
        const float excl = pre - ls; float lm = -3e38f;
#pragma unroll
        for (int k = 0; k < 4; ++k) { bc[k] += excl; av[k] = ig[k] - bc[k]; if (!(act && k < cnt)) av[k] = -1e30f; lm = fmaxf(lm, av[k]); am[k] = lm; }
        float pm = lm;
#pragma unroll
        for (int o = 1; o < 64; o <<= 1) { const float t = __shfl_up(pm, o); if (lane >= o) pm = fmaxf(pm, t); }
        float pex = __shfl_up(pm, 1); if (lane == 0) pex = -3e38f;
        const float AT = __shfl(pm, 63), BT = __shfl(pre, 63);
#pragma unroll
        for (int k = 0; k < 4; ++k) { am[k] = fmaxf(am[k], pex);
            if (act && k < cnt) { const int tl = cnt * lane + k; const int r = row0 + tl;
                wL[tl] = (AT > -1e29f) ? __expf(av[k] - AT) : 0.f;
                if (vh == 0) { BC[(size_t)r * 4 + hd] = bc[k]; AA[(size_t)r * 4 + hd] = av[k]; AM[(size_t)r * 4 + hd] = am[k]; } } }
        if (vh == 0 && lane == 0) { SEGS[(seg * 4 + hd) * 4 + 0] = AT; SEGS[(seg * 4 + hd) * 4 + 1] = BT; }
    }
    __syncthreads();
    const int l31 = lane & 31, lh = lane >> 5, wv4 = wave & 3, wk = wave >> 2;
    f32x16 acc[4];
#pragma unroll
    for (int ct = 0; ct < 4; ++ct) for (int i = 0; i < 16; ++i) acc[ct][i] = 0.f;
    float dn = 0.f;
    const int nsb = (L + 63) / 64, ntok = L < 64 ? L : 64;
    const float* wvp = p.in[I_WV];
#pragma unroll 1
    for (int sb = 0; sb < nsb; ++sb) {
        const int rs = row0 + sb * 64;
        for (int c = tid; c < 64 * 32; c += NWAVES * 64) { const int s = c & 63, kc = c >> 6;
            if (s < ntok) { const u32x4v w = *(const u32x4v*)(KB + (size_t)(rs + s) * D + hd * 256 + 8 * kc); LAS bf16* d = Kt + (8 * kc) * KT_STRIDE + s;
                d[0] = (bf16)(w.x & 0xffffu); d[KT_STRIDE] = (bf16)(w.x >> 16); d[2 * KT_STRIDE] = (bf16)(w.y & 0xffffu); d[3 * KT_STRIDE] = (bf16)(w.y >> 16);
                d[4 * KT_STRIDE] = (bf16)(w.z & 0xffffu); d[5 * KT_STRIDE] = (bf16)(w.z >> 16); d[6 * KT_STRIDE] = (bf16)(w.w & 0xffffu); d[7 * KT_STRIDE] = (bf16)(w.w >> 16); } }
        for (int c = tid; c < 64 * 32; c += NWAVES * 64) { const int s = c & 63, bq = c >> 6, gb = hd * 64 + vh * 32 + bq;
            if (s < ntok) { const u32x2v xw = *(const u32x2v*)(XM + (size_t)(rs + s) * D + 4 * gb); const float x[4] = {bflo(xw.x), bfhi(xw.x), bflo(xw.y), bfhi(xw.y)}; const float wsc = wL[sb * 64 + s];
#pragma unroll
                for (int o = 0; o < 4; ++o) { float v = 0.f;
#pragma unroll
                    for (int e = 0; e < 4; ++e) v += x[e] * wvp[(gb * 4 + e) * 4 + o];
                    Vt[(4 * bq + o) * KT_STRIDE + s] = (bf16)f2bf(v * wsc); } } }
        __syncthreads();
        const int nks = ntok / 16;
        for (int ks = 0; ks < nks; ++ks) {
            const bf16x8 bfr = *(const LAS bf16x8*)(Vt + (32 * wv4 + l31) * KT_STRIDE + 16 * ks + 8 * lh);
#pragma unroll
            for (int ct = 0; ct < 4; ++ct) { const bf16x8 afr = *(const LAS bf16x8*)(Kt + (128 * wk + 32 * ct + l31) * KT_STRIDE + 16 * ks + 8 * lh);
                acc[ct] = __builtin_amdgcn_mfma_f32_32x32x16_bf16(afr, bfr, acc[ct], 0, 0, 0); }
        }
        if (vh == 0) { const int kd = tid & 255, hf = tid >> 8; const int s0 = hf * (ntok / 2);
            for (int s = s0; s < s0 + ntok / 2; ++s) dn += bf2f(Kt[kd * KT_STRIDE + s]) * wL[sb * 64 + s]; }
        __syncthreads();
    }
    { bf16* cbase = CS + ((size_t)(seg * 4 + hd) * 256 + (128 * vh + 32 * wv4 + l31)) * 256 + 128 * wk + 4 * lh;
#pragma unroll
      for (int ct = 0; ct < 4; ++ct)
#pragma unroll
          for (int q = 0; q < 4; ++q) { u32x2v w; w.x = pk2(acc[ct][4 * q], acc[ct][4 * q + 1]); w.y = pk2(acc[ct][4 * q + 2], acc[ct][4 * q + 3]); *(u32x2v*)(cbase + 32 * ct + 8 * q) = w; } }
    if (vh == 0) { const int kd = tid & 255, hf = tid >> 8; if (hf == 1) red[kd] = dn; __syncthreads(); if (hf == 0) NS[(size_t)(seg * 4 + hd) * 256 + kd] = dn + red[kd]; }
    __syncthreads();
}
__device__ __forceinline__ void ps_scan(const Prm& p, int gtid, int ngt) {
    unsigned char* ws = p.ws; bf16* CS = (bf16*)(ws + WS_CS); float* NS = (float*)(ws + WS_NS); float* SEGS = (float*)(ws + WS_SEGS);
    constexpr int NC = SLOT / 256;
    for (int i = gtid; i < NB * 4 * 16384; i += ngt) {
        const int q = i & 16383, hd = (i >> 14) & 3, b = i >> 16; float c0 = 0.f, c1 = 0.f, c2 = 0.f, c3 = 0.f, m = 0.f;
#pragma unroll 3
        for (int c = 0; c < NC; ++c) { const int seg = b * NC + c; const float AT = SEGS[(seg * 4 + hd) * 4], BT = SEGS[(seg * 4 + hd) * 4 + 1];
            u32x2v* ptr = (u32x2v*)(CS + (size_t)(seg * 4 + hd) * 65536) + q; const u32x2v d = *ptr;
            u32x2v o; o.x = pk2(c0, c1); o.y = pk2(c2, c3); *ptr = o;
            const float mu = fmaxf(m, AT), e1 = __expf(m - mu), e2 = __expf(AT - mu);
            c0 = e1 * c0 + e2 * bflo(d.x); c1 = e1 * c1 + e2 * bfhi(d.x); c2 = e1 * c2 + e2 * bflo(d.y); c3 = e1 * c3 + e2 * bfhi(d.y); m = BT + mu; }
        *(f32x4*)(p.out + O_PC + ((size_t)(b * 4 + hd) * 16384 + q) * 4) = (f32x4){c0, c1, c2, c3};
    }
    for (int i = gtid; i < NB * 4 * 256; i += ngt) {
        const int kd = i & 255, hd = (i >> 8) & 3, b = i >> 10; float n = 0.f, m = 0.f;
        for (int c = 0; c < NC; ++c) { const int seg = b * NC + c; const float AT = SEGS[(seg * 4 + hd) * 4], BT = SEGS[(seg * 4 + hd) * 4 + 1];
            float* ptr = NS + (size_t)(seg * 4 + hd) * 256 + kd; const float d = *ptr; *ptr = n; if (kd == 0) SEGS[(seg * 4 + hd) * 4 + 2] = m;
            const float mu = fmaxf(m, AT); n = __expf(m - mu) * n + __expf(AT - mu) * d; m = BT + mu; }
        p.out[O_PN + (size_t)(b * 4 + hd) * 256 + kd] = n; if (kd == 0) p.out[O_PM + b * 4 + hd] = m;
    }
    for (int i = gtid; i < NSTR * 4 * 16384; i += ngt) {
        const int q = i & 16383, hd = (i >> 14) & 3, j = i >> 16, seg = NB * NC + j; const float AT = SEGS[(seg * 4 + hd) * 4];
        const float m = p.in[I_MLM][j * 4 + hd], mu = fmaxf(m, AT), e1 = __expf(m - mu), e2 = __expf(AT - mu);
        const f32x4 c0 = *(const f32x4*)(p.in[I_MLC] + ((size_t)(j * 4 + hd) * 16384 + q) * 4);
        u32x2v* ptr = (u32x2v*)(CS + (size_t)(seg * 4 + hd) * 65536) + q; const u32x2v d = *ptr;
        u32x2v o; o.x = pk2(c0[0], c0[1]); o.y = pk2(c0[2], c0[3]); *ptr = o;
        *(f32x4*)(p.out + O_SC + ((size_t)(j * 4 + hd) * 16384 + q) * 4) = (f32x4){e1 * c0[0] + e2 * bflo(d.x), e1 * c0[1] + e2 * bfhi(d.x), e1 * c0[2] + e2 * bflo(d.y), e1 * c0[3] + e2 * bfhi(d.y)};
    }
    for (int i = gtid; i < NSTR * 4 * 256; i += ngt) {
        const int kd = i & 255, hd = (i >> 8) & 3, j = i >> 10, seg = NB * NC + j; const float AT = SEGS[(seg * 4 + hd) * 4], BT = SEGS[(seg * 4 + hd) * 4 + 1];
        const float m = p.in[I_MLM][j * 4 + hd], mu = fmaxf(m, AT); const float n0 = p.in[I_MLN][(size_t)(j * 4 + hd) * 256 + kd];
        float* ptr = NS + (size_t)(seg * 4 + hd) * 256 + kd; const float d = *ptr; *ptr = n0;
        p.out[O_SN + (size_t)(j * 4 + hd) * 256 + kd] = __expf(m - mu) * n0 + __expf(AT - mu) * d;
        if (kd == 0) { SEGS[(seg * 4 + hd) * 4 + 2] = m; p.out[O_SM + j * 4 + hd] = BT + mu; }
    }
}
__device__ __forceinline__ void lds_addf(LAS float* q, float v) { (void)__hip_atomic_fetch_add(q, v, __ATOMIC_RELAXED, __HIP_MEMORY_SCOPE_WORKGROUP); }
constexpr int QS_STRIDE = 264;
constexpr int PO_Q_OFF = 0, PO_K_OFF = 64 * QS_STRIDE * 2  , PO_VT_OFF = 2 * PO_K_OFF  , PO_P_OFF = PO_VT_OFF + 256 * KT_STRIDE * 2  , PO_SC_OFF = PO_P_OFF + 64 * KT_STRIDE * 2  ;
__device__ __forceinline__ void po_unit(const Prm& p, LAS unsigned char* lds, int unit, int tid, int wave, int lane) {
    unsigned char* ws = p.ws; const bf16* XM = (const bf16*)(ws + WS_XM); const bf16* KB = (const bf16*)(ws + WS_XB); bf16* ZB = (bf16*)(ws + WS_Z);
    const float* BC = (const float*)(ws + WS_BC); const float* AA = (const float*)(ws + WS_AA); const float* AM = (const float*)(ws + WS_AM);
    const bf16* CS = (const bf16*)(ws + WS_CS); const float* NS = (const float*)(ws + WS_NS); const float* SEGS = (const float*)(ws + WS_SEGS); float* SQM = (float*)(ws + WS_SQM);
    const int hd = unit & 3, rb = unit >> 2, r0 = rb * 64; const bool sample = r0 >= SROW0;
    LAS bf16* Qs = (LAS bf16*)(lds + PO_Q_OFF); LAS bf16* Ks = (LAS bf16*)(lds + PO_K_OFF); LAS bf16* Vt = (LAS bf16*)(lds + PO_VT_OFF); LAS bf16* Ps = (LAS bf16*)(lds + PO_P_OFF);
    LAS float* sc = (LAS float*)(lds + PO_SC_OFF);
    LAS float* s_mu = sc, *s_ai = sc + 64, *s_emt = sc + 128, *s_as = sc + 192, *s_den = sc + 256, *s_dnq = sc + 320, *s_hs = sc + 384, *s_hq = sc + 448;
    const int l31 = lane & 31, lh = lane >> 5, l15 = lane & 15, lq = lane >> 4;
    const int seg0 = sample ? NB * (SLOT / 256) + (r0 - SROW0) / TS : r0 / 256, seg1 = sample ? seg0 + 1 : seg0;
    const int qi = sample ? 0 : (r0 & 255) >> 6;
    if (tid < 64) { const int t = tid, row = r0 + t, seg = t < 32 ? seg0 : seg1; const float mp = SEGS[(seg * 4 + hd) * 4 + 2];
        const float mu = fmaxf(mp, AM[(size_t)row * 4 + hd]); s_mu[t] = mu; s_ai[t] = __expf(mp - mu); s_emt[t] = __expf(-BC[(size_t)row * 4 + hd] - mu);
        s_den[t] = 0.f; s_dnq[t] = 0.f; s_hs[t] = 0.f; s_hq[t] = 0.f; }
    { const float* cw = p.in[I_CONVW]; const float* cb = p.in[I_CONVB]; const float* wq = p.in[I_WQ];
      for (int c = tid; c < 64 * 64; c += NWAVES * 64) { const int t = c & 63, bq = c >> 6, gb = hd * 64 + bq, ch = 4 * gb; float x0[4], x1[4], x2[4], x3[4];
          xm4_at(p, XM, r0 + t, 3, ch, x0); xm4_at(p, XM, r0 + t, 2, ch, x1); xm4_at(p, XM, r0 + t, 1, ch, x2); xm4_at(p, XM, r0 + t, 0, ch, x3);
          float xc[4], q[4];
#pragma unroll
          for (int e = 0; e < 4; ++e) xc[e] = siluf(cb[ch + e] + cw[ch + e] * x0[e] + cw[D + ch + e] * x1[e] + cw[2 * D + ch + e] * x2[e] + cw[3 * D + ch + e] * x3[e]);
#pragma unroll
          for (int o = 0; o < 4; ++o) { q[o] = 0.f;
#pragma unroll
              for (int e = 0; e < 4; ++e) q[o] += xc[e] * wq[(gb * 4 + e) * 4 + o]; }
          u32x2v w; w.x = pk2(q[0], q[1]); w.y = pk2(q[2], q[3]); *(LAS u32x2v*)(Qs + t * QS_STRIDE + 4 * bq) = w; } }
    __syncthreads();
    { const int t = tid & 63, part = tid >> 6, seg = t < 32 ? seg0 : seg1; const float* np = NS + (size_t)(seg * 4 + hd) * 256 + 32 * part; float s = 0.f;
#pragma unroll 8
      for (int d = 0; d < 32; ++d) s += np[d] * bf2f(Qs[t * QS_STRIDE + 32 * part + d]);
      lds_addf(&s_dnq[t], s); }
    f32x16 acc[2];
#pragma unroll
    for (int ct = 0; ct < 2; ++ct) for (int i = 0; i < 16; ++i) acc[ct][i] = 0.f;
    { const bf16* c0p = CS + ((size_t)(seg0 * 4 + hd) * 256 + 32 * wave + l31) * 256 + 8 * lh; const bf16* c1p = CS + ((size_t)(seg1 * 4 + hd) * 256 + 32 * wave + l31) * 256 + 8 * lh;
#pragma unroll 4
      for (int ks = 0; ks < 16; ++ks) {
          const bf16x8 a0 = *(const bf16x8*)(c0p + 16 * ks); const bf16x8 a1 = sample ? *(const bf16x8*)(c1p + 16 * ks) : a0;
          const bf16x8 b0 = *(const LAS bf16x8*)(Qs + l31 * QS_STRIDE + 16 * ks + 8 * lh), b1 = *(const LAS bf16x8*)(Qs + (32 + l31) * QS_STRIDE + 16 * ks + 8 * lh);
          acc[0] = __builtin_amdgcn_mfma_f32_32x32x16_bf16(a0, b0, acc[0], 0, 0, 0); acc[1] = __builtin_amdgcn_mfma_f32_32x32x16_bf16(a1, b1, acc[1], 0, 0, 0); }
      const float ai0 = s_ai[l31], ai1 = s_ai[32 + l31];
#pragma unroll
      for (int i = 0; i < 16; ++i) { acc[0][i] *= ai0; acc[1][i] *= ai1; } }
    const int nj = sample ? 1 : qi + 1; const float* wvp = p.in[I_WV];
#pragma unroll 1
    for (int j = 0; j < nj; ++j) {
        const int k0 = sample ? r0 : (r0 - 64 * qi + 64 * j); const bool diag = sample || (j == qi);
        __syncthreads();
        for (int c = tid; c < 64 * 32; c += NWAVES * 64) { const int s = c >> 5, kc = c & 31; *(LAS u32x4v*)(Ks + s * QS_STRIDE + 8 * kc) = *(const u32x4v*)(KB + (size_t)(k0 + s) * D + hd * 256 + 8 * kc); }
        for (int c = tid; c < 64 * 64; c += NWAVES * 64) { const int s = c & 63, bq = c >> 6, gb = hd * 64 + bq;
            const u32x2v xw = *(const u32x2v*)(XM + (size_t)(k0 + s) * D + 4 * gb); const float x[4] = {bflo(xw.x), bfhi(xw.x), bflo(xw.y), bfhi(xw.y)};
#pragma unroll
            for (int o = 0; o < 4; ++o) { float v = 0.f;
#pragma unroll
                for (int e = 0; e < 4; ++e) v += x[e] * wvp[(gb * 4 + e) * 4 + o];
                Vt[(4 * bq + o) * KT_STRIDE + s] = (bf16)f2bf(v); } }
        if (tid < 64) s_as[tid] = AA[(size_t)(k0 + tid) * 4 + hd];
        __syncthreads();
        { const int tt = wave & 3; f32x4 sa[2];
          sa[0] = (f32x4){0.f, 0.f, 0.f, 0.f}; sa[1] = sa[0];
#pragma unroll
          for (int ks = 0; ks < 8; ++ks) { const bf16x8 qf = *(const LAS bf16x8*)(Qs + (16 * tt + l15) * QS_STRIDE + 32 * ks + 8 * lq);
#pragma unroll
              for (int z = 0; z < 2; ++z) { const int st = 2 * (wave >> 2) + z; const bf16x8 kf = *(const LAS bf16x8*)(Ks + (16 * st + l15) * QS_STRIDE + 32 * ks + 8 * lq);
                  sa[z] = __builtin_amdgcn_mfma_f32_16x16x32_bf16(kf, qf, sa[z], 0, 0, 0); } }
          const int t = 16 * tt + l15; const float mu = s_mu[t];
#pragma unroll
          for (int z = 0; z < 2; ++z) { const int st = 2 * (wave >> 2) + z; float pv[4]; float ds = 0.f;
#pragma unroll
              for (int i = 0; i < 4; ++i) { const int s = 16 * st + 4 * lq + i; bool ok = true; if (diag) ok = (s <= t) && (!sample || ((s >> 5) == (t >> 5)));
                  pv[i] = ok ? sa[z][i] * __expf(s_as[s] - mu) : 0.f; ds += pv[i]; }
              u32x2v w; w.x = pk2(pv[0], pv[1]); w.y = pk2(pv[2], pv[3]); *(LAS u32x2v*)(Ps + t * KT_STRIDE + 16 * st + 4 * lq) = w;
              ds += __shfl_xor(ds, 16); ds += __shfl_xor(ds, 32);
              if (lq == 0) lds_addf(&s_den[t], ds); } }
        __syncthreads();
#pragma unroll
        for (int ks = 0; ks < 4; ++ks) { const bf16x8 vf = *(const LAS bf16x8*)(Vt + (32 * wave + l31) * KT_STRIDE + 16 * ks + 8 * lh);
            const bf16x8 p0 = *(const LAS bf16x8*)(Ps + l31 * KT_STRIDE + 16 * ks + 8 * lh), p1 = *(const LAS bf16x8*)(Ps + (32 + l31) * KT_STRIDE + 16 * ks + 8 * lh);
            acc[0] = __builtin_amdgcn_mfma_f32_32x32x16_bf16(vf, p0, acc[0], 0, 0, 0); acc[1] = __builtin_amdgcn_mfma_f32_32x32x16_bf16(vf, p1, acc[1], 0, 0, 0); }
    }
    __syncthreads();
    LAS bf16* Hs = Ks;
#pragma unroll
    for (int ct = 0; ct < 2; ++ct) { const int t = 32 * ct + l31; const float den = s_ai[t] * s_dnq[t] + s_den[t]; const float inv = 1.f / fmaxf(fabsf(den), s_emt[t]); float s1 = 0.f, s2 = 0.f;
#pragma unroll
        for (int q = 0; q < 4; ++q) { float h[4];
#pragma unroll
            for (int i = 0; i < 4; ++i) { h[i] = acc[ct][4 * q + i] * inv; s1 += h[i]; s2 += h[i] * h[i]; }
            u32x2v w; w.x = pk2(h[0], h[1]); w.y = pk2(h[2], h[3]); *(LAS u32x2v*)(Hs + t * QS_STRIDE + 32 * wave + 8 * q + 4 * lh) = w; }
        s1 += __shfl_xor(s1, 32); s2 += __shfl_xor(s2, 32);
        if (lh == 0) { lds_addf(&s_hs[t], s1); lds_addf(&s_hq[t], s2); } }
    __syncthreads();
    { const float* cw = p.in[I_CONVW]; const float* cb = p.in[I_CONVB];
      for (int c = tid; c < 64 * 32; c += NWAVES * 64) { const int vc = c & 31, t = c >> 5, row = r0 + t, ch = hd * 256 + 8 * vc;
          const float mean = s_hs[t] * (1.f / 256.f), var = fmaxf(s_hq[t] * (1.f / 256.f) - mean * mean, 0.f), rstd = rsqrtf(var + EPS);
          const u32x4v hw = *(const LAS u32x4v*)(Hs + t * QS_STRIDE + 8 * vc); const u32x4v zw = *(const u32x4v*)(ZB + (size_t)row * D + ch);
          float xa[4][8];
#pragma unroll
          for (int bk = 0; bk < 4; ++bk) { float lo[4], hi[4]; xm4_at(p, XM, row, 3 - bk, ch, lo); xm4_at(p, XM, row, 3 - bk, ch + 4, hi);
#pragma unroll
              for (int e = 0; e < 4; ++e) { xa[bk][e] = lo[e]; xa[bk][4 + e] = hi[e]; } }
          float o[8]; float ss = 0.f;
#pragma unroll
          for (int e = 0; e < 8; ++e) { const unsigned hwd = e < 2 ? hw.x : (e < 4 ? hw.y : (e < 6 ? hw.z : hw.w)), zwd = e < 2 ? zw.x : (e < 4 ? zw.y : (e < 6 ? zw.z : zw.w));
              const float h = (e & 1) ? bfhi(hwd) : bflo(hwd), z = (e & 1) ? bfhi(zwd) : bflo(zwd);
              const float xc = siluf(cb[ch + e] + cw[ch + e] * xa[0][e] + cw[D + ch + e] * xa[1][e] + cw[2 * D + ch + e] * xa[2][e] + cw[3 * D + ch + e] * xa[3][e]);
              const float hn = (h - mean) * rstd * p.in[I_MLNORM][ch + e]; o[e] = (hn + p.in[I_SKIP][ch + e] * xc) * siluf(z); ss += o[e] * o[e]; }
          u32x4v ow; ow.x = pk2(o[0], o[1]); ow.y = pk2(o[2], o[3]); ow.z = pk2(o[4], o[5]); ow.w = pk2(o[6], o[7]); *(u32x4v*)(ZB + (size_t)row * D + ch) = ow;
          ss += __shfl_xor(ss, 1); ss += __shfl_xor(ss, 2); ss += __shfl_xor(ss, 4); ss += __shfl_xor(ss, 8); ss += __shfl_xor(ss, 16);
          if (vc == 0) atomicAdd(SQM + row, ss); } }
    __syncthreads();
}
#define MIXER_PHASES \
    if (IN(PH_MG)) { for (int u = bx; u < MR / 64; u += G) pg_unit(p, lds, u, tid, wave, lane); \
                     s5_phase<false>(p, lds, bx, G, wave, lane); convout_items(p, bx * (NWAVES * 64) + tid, G * NWAVES * 64); SEAM(PH_MG); } \
    if (IN(PH_MM)) { for (int u = bx; u < NSEG * 8; u += G) pm_unit(p, lds, u, tid, wave, lane); SEAM(PH_MM); } \
    if (IN(PH_MS)) { ps_scan(p, bx * (NWAVES * 64) + tid, G * NWAVES * 64); s5_scan(p, bx * (NWAVES * 64) + tid, G * NWAVES * 64); SEAM(PH_MS); } \
    if (IN(PH_MO)) { for (int u = bx; u < (MR / 64) * 4; u += G) po_unit(p, lds, u, tid, wave, lane); \
                     s5_phase<true>(p, lds, bx, G, wave, lane); SEAM(PH_MO); }
#define HOST_PROGRAM \
    for (int ph = PH_PRO; ph <= PH_FIN; ++ph) launch_phases(p, ph, ph + 1, 0, stream);
#ifndef PG8_SP2
#define PG8_SP2 true
#endif
#ifndef PG8_ALIGN
#define PG8_ALIGN true
#endif
enum { PH_PRO = 0, PH_G1 = 1, PH_D1 = 2, PH_WIN = 3, PH_MG = 4, PH_MM = 5, PH_MS = 6, PH_MO = 7, PH_GLU = 8, PH_WOUT = 9, PH_G2 = 10, PH_D2 = 11, PH_FIN = 12, PH_N = 13 };
struct Args { Prm p; int ph_lo, ph_hi, li, pad; };
__global__ void __launch_bounds__(NWAVES * 64, 2) mk_fwd(Args a) {
    extern __shared__ __attribute__((aligned(16))) unsigned char lds_raw[];
    LAS unsigned char* lds = (LAS unsigned char*)lds_raw;
    volatile LAS unsigned* MISC = (volatile LAS unsigned*)(lds + MISC_OFF);
    const int tid = threadIdx.x, lane = tid & 63, wave = __builtin_amdgcn_readfirstlane(tid >> 6);
    const int G = gridDim.x; const int bx = blockIdx.x; const int vcu = (G % 8 == 0) ? (bx % 8) * (G / 8) + bx / 8 : bx;
    const Prm& p = a.p; unsigned char* ws = p.ws;
    gu32* ctl = (gu32*)(ws + WS_CTL);
    for (int u = tid; u < (LDS_BYTES - LDSCTL_OFF) / 4; u += NWAVES * 64) ((LAS unsigned*)(lds + LDSCTL_OFF))[u] = 0u;
    __syncthreads();
    const int lo = a.ph_lo, hi = a.ph_hi;
    const bool use_bar = (hi - lo) > 1;
    XcdBarrier bar; bar.bar = (unsigned*)(ctl + CW_BAR) + a.li * XCD_BAR_WORDS; bar.x = 0; bar.st = nullptr;
    if (use_bar) bar = xcd_barrier_post((unsigned*)(ctl + CW_BAR) + a.li * XCD_BAR_WORDS, MISC + 8);
#define IN(k) (lo <= (k) && (k) < hi)
#define SEAM(k) do { if (IN(k) && IN((k) + 1)) xcd_barrier(bar); } while (0)
    bf16* XB = (bf16*)(ws + WS_XB); bf16* HB = (bf16*)(ws + WS_H); bf16* UB = (bf16*)(ws + WS_U); bf16* XMB = (bf16*)(ws + WS_XM); bf16* ZB = (bf16*)(ws + WS_Z);
    float* SQ0 = (float*)(ws + WS_SQ0); float* SQ1 = (float*)(ws + WS_SQ1); float* SQ2 = (float*)(ws + WS_SQ2); float* SQ3 = (float*)(ws + WS_SQ3); float* SQ5 = (float*)(ws + WS_SQ5); float* SQM = (float*)(ws + WS_SQM);
    constexpr int NOSPLIT = 1 << 30;

    if (IN(PH_PRO)) { p0_prologue(p, lds, vcu, G, wave, lane); SEAM(PH_PRO); }
    if (IN(PH_G1)) {
        pg8::Gemm g{XB, (const bf16*)(ws + WS_W1GU), MR, 2 * FF, D, D, NOSPLIT, 0}; pg8::StaticOrder S; S.init(MR, 2 * FF, G, bx);
        pg8::EpiSwigluF E{SQ0, HB};
        pg8::gemm_phase<pg8::EpiSwigluF, pg8::StaticOrder, PG8_ALIGN, PG8_SP2>(lds + RING_OFF, g, S, E);
        SEAM(PH_G1);
    }
    if (IN(PH_D1)) {
        pg8::Gemm g{HB, (const bf16*)(ws + WS_W1D), MR, D, FF, FF, NOSPLIT, 0}; pg8::StaticOrder S; S.init(MR, D, G, bx);
        pg8::EpiResidF<true, false> E{p, 0.5f, nullptr, nullptr, SQ1, XB};
        pg8::gemm_phase<pg8::EpiResidF<true, false>, pg8::StaticOrder, PG8_ALIGN, PG8_SP2>(lds + RING_OFF, g, S, E);
        SEAM(PH_D1);
    }
    if (IN(PH_WIN)) {
        pg8::Gemm g{XB, (const bf16*)(ws + WS_WIN), MR, NPROJ, D, D, NOSPLIT, 0}; pg8::StaticOrder S; S.init(MR, NPROJ, G, bx);
        pg8::EpiWinF E{SQ1, UB};
        pg8::gemm_phase<pg8::EpiWinF, pg8::StaticOrder, PG8_ALIGN, PG8_SP2>(lds + RING_OFF, g, S, E);
        SEAM(PH_WIN);
    }
    MIXER_PHASES
    if (IN(PH_GLU)) {
        pg8::Gemm g{UB, (const bf16*)(ws + WS_WGLU), MR, D, D, D, NOSPLIT, 0}; pg8::StaticOrder S; S.init(MR, D, G, bx);
        pg8::EpiGluF E{UB, p.in[I_GLUB], XMB, SQ5};
        pg8::gemm_phase<pg8::EpiGluF, pg8::StaticOrder, PG8_ALIGN, PG8_SP2>(lds + RING_OFF, g, S, E);
        SEAM(PH_GLU);
    }
    if (IN(PH_WOUT)) {
        pg8::Gemm g{XMB, (const bf16*)(ws + WS_WOUT), MR, D, 2 * D, D, 16, (ptrdiff_t)WS_Z - (ptrdiff_t)WS_XM - 16 * 128}; pg8::StaticOrder S; S.init(MR, D, G, bx);
        pg8::EpiResidF<false, true> E{p, 1.0f, SQM, SQ5, SQ2, XB};
        pg8::gemm_phase<pg8::EpiResidF<false, true>, pg8::StaticOrder, PG8_ALIGN, PG8_SP2>(lds + RING_OFF, g, S, E);
        SEAM(PH_WOUT);
    }
    if (IN(PH_G2)) {
        pg8::Gemm g{XB, (const bf16*)(ws + WS_W2GU), MR, 2 * FF, D, D, NOSPLIT, 0}; pg8::StaticOrder S; S.init(MR, 2 * FF, G, bx);
        pg8::EpiSwigluF E{SQ2, HB};
        pg8::gemm_phase<pg8::EpiSwigluF, pg8::StaticOrder, PG8_ALIGN, PG8_SP2>(lds + RING_OFF, g, S, E);
        SEAM(PH_G2);
    }
    if (IN(PH_D2)) {
        pg8::Gemm g{HB, (const bf16*)(ws + WS_W2D), MR, D, FF, FF, NOSPLIT, 0}; pg8::StaticOrder S; S.init(MR, D, G, bx);
        pg8::EpiResidF<false, false> E{p, 0.5f, nullptr, nullptr, SQ3, nullptr};
        pg8::gemm_phase<pg8::EpiResidF<false, false>, pg8::StaticOrder, PG8_ALIGN, PG8_SP2>(lds + RING_OFF, g, S, E);
        SEAM(PH_D2);
    }
    if (IN(PH_FIN)) p_final(p, vcu, G, wave, lane);
#undef IN
#undef SEAM
}
static int g_grid = 0;
static void launch_phases(const Prm& p, int lo, int hi, int li, hipStream_t stream) {
    Args a{}; a.p = p; a.ph_lo = lo; a.ph_hi = hi; a.li = li; a.pad = 0;
    hipLaunchKernelGGL(mk_fwd, dim3(g_grid), dim3(NWAVES * 64), LDS_BYTES, stream, a);
}
extern "C" void kernel_launch(void* const* d_in, const int* in_sizes, int n_in, void* d_out, int out_size, void* d_ws, size_t ws_size, hipStream_t stream) {
    if (g_grid == 0) {
        if (n_in != N_IN || out_size != (int)O_END || ws_size < WS_END) { fprintf(stderr, "kernel_launch: unexpected sizes n_in %d out %d ws %zu\n", n_in, out_size, ws_size); g_grid = -1; return; }
        int dev = 0, cus = 0;
        if (hipGetDevice(&dev) != hipSuccess || hipDeviceGetAttribute(&cus, hipDeviceAttributeMultiprocessorCount, dev) != hipSuccess) { g_grid = -1; return; }
        if (hipFuncSetAttribute((const void*)mk_fwd, hipFuncAttributeMaxDynamicSharedMemorySize, LDS_BYTES) != hipSuccess) { fprintf(stderr, "kernel_launch: hipFuncSetAttribute failed\n"); g_grid = -1; return; }
        g_grid = cus;
    }
    if (g_grid < 0) return;
    Prm p{}; for (int i = 0; i < N_IN; ++i) p.in[i] = (const float*)d_in[i]; p.out = (float*)d_out; p.ws = (unsigned char*)d_ws;
    (void)hipMemsetAsync(p.ws + WS_CTL, 0, CTL_ZERO_BYTES, stream);
    HOST_PROGRAM
}
```

```cpp
#include <hip/hip_runtime.h>
#include <cstdio>
#include <cstdint>

constexpr int D = 1024, FF = 2816, NPROJ = 3072, SEQ = 8192, NB = 2, NMETA = 16, NSTR = 16, TS = 32;
constexpr int SLOT = 8448, PADL = 240;
constexpr int MR = NB * SLOT + NSTR * TS;
constexpr int SROW0 = NB * SLOT;
constexpr int NG5 = 64, NP5 = 64, NH5 = 16;
constexpr int NHEAD = 4, HD = 256;
constexpr float EPS = 1e-6f;
constexpr int NSEG = NB * (SLOT / 256) + NSTR;
constexpr int NCH64 = MR / 64;

enum { I_XP = 0, I_XS, I_S5RE, I_S5IM, I_MLC, I_MLN, I_MLM, I_MLCONV, I_META, I_NORM1, I_G1, I_U1, I_D1, I_NORMMIX, I_WIN,
       I_LRE, I_LIM, I_LOGDT, I_BRE, I_BIM, I_CRE, I_CIM, I_S5D, I_GLUW, I_GLUB, I_CONVW, I_CONVB, I_WQ, I_WK, I_WV, I_IGW, I_IGB, I_FGW, I_FGB,
       I_MLNORM, I_SKIP, I_ONS5, I_ONML, I_WOUT, I_NORM2, I_G2, I_U2, I_D2, I_NORMF, N_IN };

constexpr size_t O_YP = 0, O_YS = 16777216, O_PS5R = 17301504, O_PS5I = 17309696, O_PC = 17317888, O_PN = 17842176, O_PM = 17844224, O_PCONV = 17844232,
                 O_SS5R = 17850376, O_SS5I = 17915912, O_SC = 17981448, O_SN = 22175752, O_SM = 22192136, O_SCONV = 22192200, O_END = 22241352;

constexpr size_t MiB = 1u << 20;
constexpr size_t WS_CTL = 0, CTL_ZERO_BYTES = 1 * MiB;
constexpr size_t SQ_BYTES = (size_t)MR * 4;
constexpr size_t WS_SQ1 = 128 * 1024, WS_SQ2 = WS_SQ1 + SQ_BYTES, WS_SQ3 = WS_SQ2 + SQ_BYTES, WS_SQ5 = WS_SQ3 + SQ_BYTES, WS_SQM = WS_SQ5 + SQ_BYTES;
static_assert(WS_SQM + SQ_BYTES <= CTL_ZERO_BYTES, "zeroed region");
constexpr size_t WS_TBL = 1 * MiB;
constexpr size_t WS_SQ0 = WS_TBL;
constexpr size_t WS_LAMB = WS_TBL + 128 * 1024;
constexpr size_t WS_LAM64 = WS_LAMB + 32 * 1024;
constexpr size_t WS_BBF = WS_TBL + 256 * 1024;
constexpr size_t WS_BB = WS_TBL + 768 * 1024;
constexpr size_t WS_CMB = WS_TBL + 1024 * 1024;
constexpr size_t WS_GWT = WS_TBL + 1280 * 1024;
constexpr size_t WS_W1GU = 4 * MiB, WS_W1D = 15 * MiB, WS_WIN = 21 * MiB, WS_WGLU = 27 * MiB, WS_WOUT = 29 * MiB, WS_W2GU = 33 * MiB, WS_W2D = 44 * MiB;
constexpr size_t WS_XB = 50 * MiB;
constexpr size_t WS_U = 84 * MiB, WS_XM = 118 * MiB, WS_Z = 152 * MiB;
constexpr size_t WS_H = 84 * MiB;
constexpr size_t WS_CS = 186 * MiB;
constexpr size_t WS_DS = 227 * MiB;
constexpr size_t WS_XSIDE = 236 * MiB;
constexpr size_t WS_IG = 238 * MiB, WS_LF = WS_IG + (size_t)MR * 16, WS_BC = WS_LF + (size_t)MR * 16, WS_AA = WS_BC + (size_t)MR * 16, WS_AM = WS_AA + (size_t)MR * 16;
constexpr size_t WS_NS = 240 * MiB;
constexpr size_t WS_SEGS = WS_NS + (size_t)NSEG * 4 * 256 * 4;
constexpr size_t WS_END = 241 * MiB;
static_assert(WS_H + (size_t)MR * FF * 2 <= WS_CS && WS_CS + (size_t)NSEG * 4 * 65536 * 2 <= WS_DS && WS_DS + (size_t)NCH64 * 4096 * 8 <= WS_XSIDE && WS_AM + (size_t)MR * 16 <= WS_NS && WS_SEGS + NSEG * 64 <= WS_END, "ws map");
static_assert(WS_W2D + (size_t)D * FF * 2 <= WS_XB && WS_W1GU + (size_t)2 * FF * D * 2 <= WS_W1D && WS_GWT + 16 * 3072 * 2 <= WS_W1GU, "ws map 2");

typedef unsigned short bf16;
__device__ __forceinline__ float bf2f(bf16 v) { return __uint_as_float((unsigned)v << 16); }
__device__ __forceinline__ unsigned f2bf(float f) { unsigned u = __float_as_uint(f); return (u + 0x7fffu + ((u >> 16) & 1u)) >> 16; }
__device__ __forceinline__ unsigned pk2(float lo, float hi) { return f2bf(lo) | (f2bf(hi) << 16); }
__device__ __forceinline__ float siluf(float x) { return x / (1.f + __expf(-x)); }
__device__ __forceinline__ float sigmf(float x) { return 1.f / (1.f + __expf(-x)); }
__device__ __forceinline__ float logsigf(float x) { return x >= 0.f ? -log1pf(__expf(-x)) : x - log1pf(__expf(x)); }
__device__ __forceinline__ float geluf(float x) { const float t = tanhf(0.7978845608028654f * (x + 0.044715f * x * x * x)); return 0.5f * x * (1.f + t); }

struct Prm { const float* in[N_IN]; float* out; unsigned char* ws; };

__device__ __forceinline__ const float* xsrc_row(const Prm& p, int r) {
    if (r >= SROW0) return p.in[I_XS] + (size_t)(r - SROW0) * D;
    const int b = r >= SLOT ? 1 : 0, tp = r - b * SLOT;
    if (tp < PADL) return nullptr;
    if (tp < 256) return p.in[I_META] + (size_t)(tp - PADL) * D;
    return p.in[I_XP] + ((size_t)b * SEQ + (tp - 256)) * D;
}
__device__ __forceinline__ float* xrow(const Prm& p, int r) {
    if (r >= SROW0) return p.out + O_YS + (size_t)(r - SROW0) * D;
    const int b = r >= SLOT ? 1 : 0, tp = r - b * SLOT;
    if (tp < 256) return (float*)(p.ws + WS_XSIDE) + (size_t)(b * 256 + tp) * D;
    return p.out + O_YP + ((size_t)b * SEQ + (tp - 256)) * D;
}
__device__ __forceinline__ bool row_is_pad(int r) { if (r >= SROW0) return false; const int tp = r >= SLOT ? r - SLOT : r; return tp < PADL; }
__device__ __forceinline__ float xm_at(const Prm& p, const bf16* XM, int r, int back, int ch) {
    if (r >= SROW0) { const int j = (r - SROW0) / TS, t = (r - SROW0) % TS - back; if (t >= 0) return bf2f(XM[(size_t)(r - back) * D + ch]); return p.in[I_MLCONV][((size_t)j * 3 + (3 + t)) * D + ch]; }
    const int b = r >= SLOT ? 1 : 0, tp = r - b * SLOT - back;
    if (tp < 0) return 0.f;
    return bf2f(XM[(size_t)(r - back) * D + ch]);
}
__device__ __forceinline__ float rstd_of(float sumsq) { return rsqrtf(sumsq * (1.0f / D) + EPS); }
__device__ __forceinline__ float wave_sum(float v) {
#pragma unroll
    for (int o = 1; o < 64; o <<= 1) v += __shfl_xor(v, o);
    return v;
}
namespace pg8 {
#define PG8_LAS __attribute__((address_space(3)))
typedef unsigned short bf16_t;
typedef short bf16x8 __attribute__((ext_vector_type(8)));
typedef float f32x4 __attribute__((ext_vector_type(4)));
typedef unsigned u32x4 __attribute__((ext_vector_type(4)));
typedef unsigned u32x2 __attribute__((ext_vector_type(2)));
constexpr int BM = 256, BK = 64, HALF = 128, HTB = HALF * BK * 2  , STAGE_BYTES = 8 * HTB, NXCD = 8, WGM = 8;
__host__ __device__ __forceinline__ int lds_byte(int r, int c) { const int st = (r >> 4) * 2 + (c >> 5), rr = r & 15, cc = c & 31, ob = rr * 64 + cc * 2; return st * 1024 + (ob ^ (((ob >> 9) & 1) << 5)); }
__host__ __device__ __forceinline__ void stage_rc(int b, int& R, int& C) { const int st = b / 1024, sb = b % 1024, swz = sb ^ (((sb >> 9) & 1) << 5); R = (st >> 1) * 16 + swz / 64; C = (st & 1) * 32 + (swz % 64) / 2; }
__host__ __device__ __forceinline__ int perm32(int rho) { const int n = rho >> 4, i = rho & 15; return 8 * (i >> 2) + 4 * n + (i & 3); }
struct Unit { int pm, pn; };
struct Gemm { const bf16_t* A; const bf16_t* Bt; int M, N, K, lda, ks; ptrdiff_t dA; };
struct StaticOrder {
    int nM, nN, nwg, G, c;
    __host__ __device__ void init(int M, int N, int G_, int c_) { nM = M / BM; nN = N / BM; nwg = nM * nN; G = G_; c = c_; }
    __host__ __device__ bool next(int i, Unit& u) const {
        const long L = (long)i * G + c; if (L >= nwg) return false;
        int wgid = (int)L; { const int q = nwg / NXCD, r = nwg % NXCD, xcd = wgid % NXCD, off = wgid / NXCD; wgid = (xcd < r ? xcd * (q + 1) : r * (q + 1) + (xcd - r) * q) + off; }
        const int nig = WGM * nN, gid = wgid / nig, fm = gid * WGM, gsz = (nM - fm) < WGM ? (nM - fm) : WGM;
        u.pm = fm + ((wgid % nig) % gsz); u.pn = (wgid % nig) / gsz; return true;
    }
    __device__ __forceinline__ void a_ready(const Unit&) const {}
    __device__ __forceinline__ void done(const Unit&) const {}
};
__device__ __forceinline__ unsigned cvt_pk_bf16(float lo, float hi) { unsigned r; asm volatile("v_cvt_pk_bf16_f32 %0, %1, %2" : "=v"(r) : "v"(lo), "v"(hi)); return r; }
struct EpiSwigluF {
    static constexpr bool PERM = true, AFTER_DRAIN = false, HAS_MID = false;
    const float* SQ; bf16_t* H;
    __device__ __forceinline__ void mid(f32x4 (&)[2][2][4][2], const Unit&, int, int) const {}
    __device__ __forceinline__ void operator()(const f32x4 (&acc)[2][2][4][2], const Unit& u, int wr, int wc, int fr, int fq) const {
        const int row0 = u.pm * BM + wr * 64 + fr, hc0 = (u.pn * BM + wc * 32 + 8 * fq) >> 1;
#pragma unroll
        for (int ai = 0; ai < 2; ++ai)
#pragma unroll
            for (int m = 0; m < 4; ++m) { const int r = row0 + ai * HALF + m * 16; const float rs = rstd_of(SQ[r]); bf16_t* rowp = H + (size_t)r * FF + hc0;
#pragma unroll
                for (int bj = 0; bj < 2; ++bj) { const f32x4 g = acc[ai][bj][m][0] * rs, up = acc[ai][bj][m][1] * rs; u32x2 w;
                    w.x = cvt_pk_bf16(siluf(g[0]) * up[0], siluf(g[1]) * up[1]); w.y = cvt_pk_bf16(siluf(g[2]) * up[2], siluf(g[3]) * up[3]);
                    *(u32x2*)(rowp + bj * (HALF / 2)) = w; } }
    }
};
template <bool FIRST, bool MID> struct EpiResidF {
    static constexpr bool PERM = false, AFTER_DRAIN = false, HAS_MID = MID;
    Prm p; float scale; const float* SQrow; const float* SQmid; float* SQacc; bf16_t* XB;
    __device__ __forceinline__ void mid(f32x4 (&acc)[2][2][4][2], const Unit& u, int wr, int fr_) const {
        int fr = fr_; asm volatile("" : "+v"(fr));
#pragma unroll
        for (int ai = 0; ai < 2; ++ai)
#pragma unroll
            for (int m = 0; m < 4; ++m) { const int r = u.pm * BM + ai * HALF + wr * 64 + m * 16 + fr; const float ratio = rstd_of(SQmid[r]) / rstd_of(SQrow[r]);
#pragma unroll
                for (int bj = 0; bj < 2; ++bj)
#pragma unroll
                    for (int n = 0; n < 2; ++n) acc[ai][bj][m][n] = acc[ai][bj][m][n] * ratio;
                asm volatile("" ::: "memory"); }
    }
    __device__ __forceinline__ void operator()(const f32x4 (&acc)[2][2][4][2], const Unit& u, int wr, int wc, int fr, int fq) const {
        const int row0 = u.pm * BM + wr * 64 + fr, col0 = u.pn * BM + wc * 32 + 4 * fq;
#pragma unroll
        for (int ai = 0; ai < 2; ++ai)
#pragma unroll
            for (int m = 0; m < 4; ++m) { const int r = row0 + ai * HALF + m * 16; float* xr = xrow(p, r); const float* src = FIRST ? xsrc_row(p, r) : xr;
                const float sc = scale * (SQrow ? rstd_of(SQrow[r]) : 1.f); float ss = 0.f;
#pragma unroll
                for (int bj = 0; bj < 2; ++bj)
#pragma unroll
                    for (int n = 0; n < 2; ++n) { const int c = col0 + bj * HALF + n * 16; f32x4 xo = (f32x4){0.f, 0.f, 0.f, 0.f}; if (!FIRST || src) xo = *(const f32x4*)(src + c);
                        const f32x4 xn = xo + acc[ai][bj][m][n] * sc; *(f32x4*)(xr + c) = xn; ss += (xn[0] * xn[0] + xn[1] * xn[1]) + (xn[2] * xn[2] + xn[3] * xn[3]);
                        if (XB) { u32x2 w; w.x = cvt_pk_bf16(xn[0], xn[1]); w.y = cvt_pk_bf16(xn[2], xn[3]); *(u32x2*)(XB + (size_t)r * D + c) = w; } }
                ss += __shfl_xor(ss, 16); ss += __shfl_xor(ss, 32);
                if (fq == 0) atomicAdd(SQacc + r, ss); }
    }
};
struct EpiWinF {
    static constexpr bool PERM = true, AFTER_DRAIN = false, HAS_MID = false;
    const float* SQ; bf16_t* U;
    __device__ __forceinline__ void mid(f32x4 (&)[2][2][4][2], const Unit&, int, int) const {}
    __device__ __forceinline__ void operator()(const f32x4 (&acc)[2][2][4][2], const Unit& u, int wr, int wc, int fr, int fq) const {
        const int row0 = u.pm * BM + wr * 64 + fr; const int t = u.pn >> 2; bf16_t* base = U + (size_t)t * ((WS_XM - WS_U) / 2);
        const int col0 = (u.pn & 3) * BM + wc * 32 + 8 * fq;
#pragma unroll
        for (int ai = 0; ai < 2; ++ai)
#pragma unroll
            for (int m = 0; m < 4; ++m) { const int r = row0 + ai * HALF + m * 16; const float rs = rstd_of(SQ[r]); bf16_t* rowp = base + (size_t)r * D + col0;
#pragma unroll
                for (int bj = 0; bj < 2; ++bj) { const f32x4 v0 = acc[ai][bj][m][0] * rs, v1 = acc[ai][bj][m][1] * rs; u32x4 w;
                    w.x = cvt_pk_bf16(v0[0], v0[1]); w.y = cvt_pk_bf16(v0[2], v0[3]); w.z = cvt_pk_bf16(v1[0], v1[1]); w.w = cvt_pk_bf16(v1[2], v1[3]);
                    *(u32x4*)(rowp + bj * HALF) = w; } }
    }
};
struct EpiGluF {
    static constexpr bool PERM = true, AFTER_DRAIN = false, HAS_MID = false;
    const bf16_t* G; const float* bias; bf16_t* Y5; float* SQ5;
    __device__ __forceinline__ void mid(f32x4 (&)[2][2][4][2], const Unit&, int, int) const {}
    __device__ __forceinline__ void operator()(const f32x4 (&acc)[2][2][4][2], const Unit& u, int wr, int wc, int fr, int fq) const {
        const int row0 = u.pm * BM + wr * 64 + fr, col0 = u.pn * BM + wc * 32 + 8 * fq;
        f32x4 bv[2][2];
#pragma unroll
        for (int bj = 0; bj < 2; ++bj)
#pragma unroll
            for (int n = 0; n < 2; ++n) bv[bj][n] = *(const f32x4*)(bias + col0 + bj * HALF + 4 * n);
#pragma unroll
        for (int ai = 0; ai < 2; ++ai)
#pragma unroll
            for (int m = 0; m < 4; ++m) { const int r = row0 + ai * HALF + m * 16; float ss = 0.f;
#pragma unroll
                for (int bj = 0; bj < 2; ++bj) { const size_t off = (size_t)r * D + col0 + bj * HALF; const u32x4 gw = *(const u32x4*)(G + off); float y[8];
#pragma unroll
                    for (int n = 0; n < 2; ++n)
#pragma unroll
                        for (int e = 0; e < 4; ++e) { const unsigned wd = n == 0 ? (e < 2 ? gw.x : gw.y) : (e < 2 ? gw.z : gw.w); const float g = __uint_as_float((e & 1) ? (wd & 0xffff0000u) : (wd << 16));
                            const float v = g * sigmf(acc[ai][bj][m][n][e] + bv[bj][n][e]); y[4 * n + e] = v; ss += v * v; }
                    u32x4 w; w.x = cvt_pk_bf16(y[0], y[1]); w.y = cvt_pk_bf16(y[2], y[3]); w.z = cvt_pk_bf16(y[4], y[5]); w.w = cvt_pk_bf16(y[6], y[7]);
                    *(u32x4*)(Y5 + off) = w; }
                ss += __shfl_xor(ss, 16); ss += __shfl_xor(ss, 32);
                if (fq == 0) atomicAdd(SQ5 + r, ss); }
    }
};
template <class Epi, class Sched, bool ALIGN_EPI = false, bool SP2 = false>
__device__ __forceinline__ void gemm_phase(PG8_LAS unsigned char* lds, const Gemm g, const Sched& S, const Epi& E) {
    const int tid = threadIdx.x, wid = __builtin_amdgcn_readfirstlane(tid >> 6), lane = tid & 63, wr = wid >> 2, wc = wid & 3, fr = lane & 15, fq = lane >> 4;
    const int K = g.K, nt = K / BK;
    unsigned voffA[2], voffB[2];
#pragma unroll
    for (int i = 0; i < 2; ++i) { int R, C; stage_rc(tid * 16 + i * 8192, R, C); const int Rb = Epi::PERM ? ((R & ~31) + perm32(R & 31)) : R;
        voffA[i] = (unsigned)(R * g.lda + C) * 2u; voffB[i] = (unsigned)(Rb * K + C) * 2u; }
    const size_t kstep = (size_t)(BK * 2);
    const size_t hstepA = (size_t)HALF * g.lda * 2, hstepB = (size_t)HALF * K * 2;
    const size_t tstepA = 2 * hstepA, tstepB = 2 * hstepB;
    const unsigned ldsw = (unsigned)wid * 1024u;
    const int aoff = lds_byte(wr * 64 + fr, fq * 8), boff = lds_byte(wc * 32 + fr, fq * 8);
#define PG8_SA(b, h) (((b) * 2 + (h)) * HTB)
#define PG8_SB(b, h) ((4 + (b) * 2 + (h)) * HTB)
#define PG8_STAGE(bufoff, gbase, voff) do { _Pragma("unroll") for (int _i = 0; _i < 2; ++_i) \
        __builtin_amdgcn_global_load_lds((const unsigned*)((const char*)(gbase) + (voff)[_i]), (PG8_LAS unsigned*)(lds + (bufoff) + ldsw + _i * 8192), 16, 0, 0); } while (0)
#define PG8_LDA(dst, b, h) do { _Pragma("unroll") for (int m = 0; m < 4; ++m) _Pragma("unroll") for (int k = 0; k < 2; ++k) dst[m][k] = *(const PG8_LAS bf16x8*)(lds + PG8_SA(b, h) + aoff + m * 2048 + k * 1024); } while (0)
#define PG8_LDB(dst, b, h) do { _Pragma("unroll") for (int n = 0; n < 2; ++n) _Pragma("unroll") for (int k = 0; k < 2; ++k) dst[n][k] = *(const PG8_LAS bf16x8*)(lds + PG8_SB(b, h) + boff + n * 2048 + k * 1024); } while (0)
#define PG8_MMA(ai, bj, At, Bt) do { __builtin_amdgcn_s_setprio(1); _Pragma("unroll") for (int m = 0; m < 4; ++m) _Pragma("unroll") for (int n = 0; n < 2; ++n) _Pragma("unroll") for (int k = 0; k < 2; ++k) \
        acc[ai][bj][m][n] = __builtin_amdgcn_mfma_f32_16x16x32_bf16(Bt[n][k], At[m][k], acc[ai][bj][m][n], 0, 0, 0); __builtin_amdgcn_s_setprio(0); } while (0)
#define PG8_WAIT_V(n) asm volatile("s_waitcnt vmcnt(" #n ")" ::: "memory")
#define PG8_WAIT_L(n) asm volatile("s_waitcnt lgkmcnt(" #n ")" ::: "memory")
#define PG8_BAR __builtin_amdgcn_s_barrier()
#define PG8_SCHED __builtin_amdgcn_sched_barrier(0)
    Unit cur, nxt; int ui = 0;
    if (!S.next(0, cur)) return;
    f32x4 acc[2][2][4][2];
#pragma unroll
    for (int a = 0; a < 2; ++a)
#pragma unroll
        for (int b = 0; b < 2; ++b)
#pragma unroll
            for (int m = 0; m < 4; ++m)
#pragma unroll
                for (int n = 0; n < 2; ++n) acc[a][b][m][n] = (f32x4){0.f, 0.f, 0.f, 0.f};
    bf16x8 At[4][2], B0[2][2], B1[2][2];
    const char* cA = (const char*)g.A + (size_t)cur.pm * tstepA; const char* cB = (const char*)g.Bt + (size_t)cur.pn * tstepB;
    S.a_ready(cur);
    if constexpr (SP2) {
        PG8_STAGE(PG8_SB(0, 0), cB, voffB); PG8_STAGE(PG8_SB(0, 1), cB + hstepB, voffB); PG8_STAGE(PG8_SA(0, 0), cA, voffA); PG8_STAGE(PG8_SA(0, 1), cA + hstepA, voffA);
        if (wr == 1) PG8_BAR;
        PG8_WAIT_V(2); PG8_BAR;
        PG8_STAGE(PG8_SB(1, 0), cB + kstep, voffB); PG8_STAGE(PG8_SA(1, 0), cA + kstep, voffA); PG8_STAGE(PG8_SB(1, 1), cB + hstepB + kstep, voffB);
        PG8_WAIT_V(6); PG8_BAR;
    } else {
        PG8_STAGE(PG8_SB(0, 0), cB, voffB); PG8_STAGE(PG8_SA(0, 0), cA, voffA); PG8_STAGE(PG8_SB(0, 1), cB + hstepB, voffB); PG8_STAGE(PG8_SA(0, 1), cA + hstepA, voffA);
        if (wr == 1) PG8_BAR;
        PG8_WAIT_V(4); PG8_BAR;
        PG8_STAGE(PG8_SB(1, 0), cB + kstep, voffB); PG8_STAGE(PG8_SA(1, 0), cA + kstep, voffA); PG8_STAGE(PG8_SB(1, 1), cB + hstepB + kstep, voffB);
        PG8_WAIT_V(6); PG8_BAR;
    }
    for (;;) {
        const bool has_next = S.next(ui + 1, nxt);
        const char* nA = has_next ? (const char*)g.A + (size_t)nxt.pm * tstepA : cA; const char* nB = has_next ? (const char*)g.Bt + (size_t)nxt.pn * tstepB : cB;
        for (int t = 0; t < nt; t += 2) {
            const bool last = (t == nt - 2);
            if constexpr (Epi::HAS_MID) { if (t == g.ks) E.mid(acc, cur, wr, fr); }
            const char* a1 = cA + (size_t)(t + 1) * kstep + ((t + 1) >= g.ks ? g.dA : (ptrdiff_t)0);
            const char* a2 = last ? nA : cA + (size_t)(t + 2) * kstep + ((t + 2) >= g.ks ? g.dA : (ptrdiff_t)0); const char* b2 = last ? nB : cB + (size_t)(t + 2) * kstep;
            const char* a3 = last ? nA + kstep : cA + (size_t)(t + 3) * kstep + ((t + 3) >= g.ks ? g.dA : (ptrdiff_t)0); const char* b3 = b2 + kstep;
            if (last && has_next) S.a_ready(nxt);
            if constexpr (SP2) {
            PG8_LDB(B0, 0, 0); PG8_LDB(B1, 0, 1); PG8_SCHED; PG8_LDA(At, 0, 0); PG8_STAGE(PG8_SA(1, 1), a1 + hstepA, voffA);
            PG8_WAIT_V(8); PG8_WAIT_L(0); PG8_BAR; PG8_MMA(0, 0, At, B0); PG8_MMA(0, 1, At, B1); PG8_BAR; PG8_SCHED;
            PG8_LDA(At, 0, 1); PG8_STAGE(PG8_SB(0, 0), b2, voffB); PG8_STAGE(PG8_SB(0, 1), b2 + hstepB, voffB); PG8_STAGE(PG8_SA(0, 0), a2, voffA);
            PG8_WAIT_V(8); PG8_WAIT_L(0); PG8_BAR; PG8_MMA(1, 0, At, B0); PG8_MMA(1, 1, At, B1); PG8_BAR; PG8_SCHED;
            PG8_LDB(B0, 1, 0); PG8_LDB(B1, 1, 1); PG8_SCHED; PG8_LDA(At, 1, 0); PG8_STAGE(PG8_SA(0, 1), a2 + hstepA, voffA);
            PG8_WAIT_V(8); PG8_WAIT_L(0); PG8_BAR; PG8_MMA(0, 0, At, B0); PG8_MMA(0, 1, At, B1); PG8_BAR; PG8_SCHED;
            PG8_LDA(At, 1, 1); PG8_STAGE(PG8_SB(1, 0), b3, voffB); PG8_STAGE(PG8_SB(1, 1), b3 + hstepB, voffB); PG8_STAGE(PG8_SA(1, 0), a3, voffA);
            PG8_WAIT_V(8); PG8_WAIT_L(0); PG8_BAR; PG8_MMA(1, 0, At, B0); PG8_MMA(1, 1, At, B1); PG8_BAR; PG8_SCHED;
            } else {
            PG8_LDB(B0, 0, 0); PG8_SCHED; PG8_LDA(At, 0, 0); PG8_STAGE(PG8_SA(1, 1), a1 + hstepA, voffA);
            PG8_WAIT_L(8); PG8_BAR; PG8_WAIT_L(0); PG8_MMA(0, 0, At, B0); PG8_BAR; PG8_SCHED;
            PG8_LDB(B1, 0, 1); PG8_STAGE(PG8_SB(0, 0), b2, voffB);
            PG8_BAR; PG8_WAIT_L(0); PG8_MMA(0, 1, At, B1); PG8_BAR;
            PG8_LDA(At, 0, 1); PG8_STAGE(PG8_SA(0, 0), a2, voffA);
            PG8_BAR; PG8_WAIT_L(0); PG8_MMA(1, 0, At, B0); PG8_BAR; PG8_SCHED;
            PG8_STAGE(PG8_SB(0, 1), b2 + hstepB, voffB);
            PG8_WAIT_V(6); PG8_BAR; PG8_MMA(1, 1, At, B1); PG8_BAR;
            PG8_LDB(B0, 1, 0); PG8_SCHED; PG8_LDA(At, 1, 0); PG8_STAGE(PG8_SA(0, 1), a2 + hstepA, voffA);
            PG8_WAIT_L(8); PG8_BAR; PG8_WAIT_L(0); PG8_MMA(0, 0, At, B0); PG8_BAR; PG8_SCHED;
            PG8_LDB(B1, 1, 1); PG8_STAGE(PG8_SB(1, 0), b3, voffB);
            PG8_BAR; PG8_WAIT_L(0); PG8_MMA(0, 1, At, B1); PG8_BAR;
            PG8_LDA(At, 1, 1); PG8_STAGE(PG8_SA(1, 0), a3, voffA);
            PG8_BAR; PG8_WAIT_L(0); PG8_MMA(1, 0, At, B0); PG8_BAR; PG8_SCHED;
            PG8_STAGE(PG8_SB(1, 1), b3 + hstepB, voffB);
            PG8_WAIT_V(6); PG8_BAR; PG8_MMA(1, 1, At, B1); PG8_BAR;
            }
        }
        if constexpr (ALIGN_EPI) { if (wr == 0) PG8_BAR; }
        if constexpr (!Epi::AFTER_DRAIN) { E(acc, cur, wr, wc, fr, fq); S.done(cur); }
        if (!has_next) break;
#pragma unroll
        for (int a = 0; a < 2; ++a)
#pragma unroll
            for (int b = 0; b < 2; ++b)
#pragma unroll
                for (int m = 0; m < 4; ++m)
#pragma unroll
                    for (int n = 0; n < 2; ++n) acc[a][b][m][n] = (f32x4){0.f, 0.f, 0.f, 0.f};
        cur = nxt; cA = nA; cB = nB; ++ui;
        if constexpr (ALIGN_EPI) { if (wr == 1) PG8_BAR; }
    }
    PG8_WAIT_V(0);
    if constexpr (!ALIGN_EPI) { if (wr == 0) PG8_BAR; }
    PG8_BAR;
    if constexpr (Epi::AFTER_DRAIN) { E.fused(acc, cur, wr, wc, fr, fq, lds, wid, lane); S.done(cur); }
#undef PG8_SA
#undef PG8_SB
#undef PG8_STAGE
#undef PG8_LDA
#undef PG8_LDB
#undef PG8_MMA
#undef PG8_WAIT_V
#undef PG8_WAIT_L
#undef PG8_BAR
#undef PG8_SCHED
}}
constexpr int NWAVES = 8;
constexpr int RING_OFF = 0;
constexpr int LDS_BYTES = 163840;
constexpr int LDSCTL_OFF = LDS_BYTES - 512, MISC_OFF = LDSCTL_OFF + 320;
constexpr int CW_TMO = 0, CW_CODE = 1, CW_BAR = 4096;
#define GAS __attribute__((address_space(1)))
#define LAS __attribute__((address_space(3)))
typedef unsigned v4u __attribute__((ext_vector_type(4)));
typedef float f32x4 __attribute__((ext_vector_type(4)));
typedef short bf16x8 __attribute__((ext_vector_type(8)));
typedef GAS unsigned gu32;
#define RLX_AGENT __ATOMIC_RELAXED, __HIP_MEMORY_SCOPE_AGENT
#define LDS_WAIT() asm volatile("s_waitcnt lgkmcnt(0)" ::: "memory")
#define VM_WAIT() asm volatile("s_waitcnt vmcnt(0)" ::: "memory")
#define XB_TMO      128
#define XB_XCNT(j)  (256  + 64 * (j))
#define XB_XSUB(j)  (1280 + 64 * (j))
#define XB_XGEN(j)  (2304 + 64 * (j))
#define XB_TOP      3328
#define XB_TOPGEN   3392
#define XCD_BAR_WORDS 3456
#define XB_SPIN_CAP (1u << 18)
__device__ __forceinline__ unsigned xb_ld(unsigned* p)              { return __hip_atomic_load(p, __ATOMIC_RELAXED, __HIP_MEMORY_SCOPE_AGENT); }
__device__ __forceinline__ unsigned xb_add(unsigned* p, unsigned v) { return __hip_atomic_fetch_add(p, v, __ATOMIC_RELAXED, __HIP_MEMORY_SCOPE_AGENT); }
__device__ __forceinline__ unsigned xb_xcc_id() { return (unsigned)__builtin_amdgcn_s_getreg((3 << 11) | 20) & 0xFu; }
#define XB_SPIN(cond, bar) do { unsigned _sp = 0; while (cond) { __builtin_amdgcn_s_sleep(1); \
    if ((++_sp & 255u) == 0u) { if (xb_ld(&(bar)[XB_TMO])) break; if (_sp > XB_SPIN_CAP) { atomicAdd(&(bar)[XB_TMO], 1u); break; } } } } while (0)
struct XcdBarrier { unsigned* bar; unsigned x; volatile LAS unsigned* st; };
__device__ __forceinline__ XcdBarrier xcd_barrier_post(unsigned* bar, volatile LAS unsigned* st) {
    XcdBarrier b; b.bar = bar; b.x = xb_xcc_id(); b.st = st;
    if (threadIdx.x == 0) (void)xb_add(&bar[XB_XCNT(b.x)], 1u);
    return b;
}
__device__ __forceinline__ void xcd_barrier_complete(unsigned* bar, unsigned x, unsigned& nloc, unsigned& nx) {
    const unsigned G = gridDim.x * gridDim.y * gridDim.z;
    unsigned sum, cnt, mine, sp = 0u;
    for (;;) {
        sum = 0u; cnt = 0u; mine = 0u;
#pragma unroll
        for (unsigned j = 0; j < 16; ++j) { const unsigned c = xb_ld(&bar[XB_XCNT(j)]); sum += c; cnt += (c > 0u) ? 1u : 0u; mine = (j == x) ? c : mine; }
        if (sum == G) break;
        __builtin_amdgcn_s_sleep(1);
        if ((++sp & 255u) == 0u) { if (xb_ld(&bar[XB_TMO])) break; if (sp > XB_SPIN_CAP) { atomicAdd(&bar[XB_TMO], 1u); break; } }
    }
    nloc = mine > 0u ? mine : 1u; nx = cnt > 0u ? cnt : 1u;
}
__device__ __forceinline__ void xcd_barrier(const XcdBarrier& b) {
    asm volatile("s_waitcnt vmcnt(0)" ::: "memory");
    __syncthreads();
    if (threadIdx.x == 0) {
        unsigned* bar = b.bar;
        __builtin_amdgcn_s_waitcnt(0);
        unsigned nloc = b.st[0], nx = b.st[1];
        if (nloc == 0u) { xcd_barrier_complete(bar, b.x, nloc, nx); b.st[0] = nloc; b.st[1] = nx; }
        const unsigned old = xb_add(&bar[XB_XSUB(b.x)], 1u);
        const unsigned gen = old / nloc;
        if (old + 1u == (gen + 1u) * nloc) {
            __builtin_amdgcn_fence(__ATOMIC_RELEASE, "agent");
            asm volatile("s_waitcnt vmcnt(0)" ::: "memory");
            const unsigned og = xb_add(&bar[XB_TOP], 1u);
            const unsigned tg = og / nx;
            if (og + 1u == (tg + 1u) * nx) xb_add(&bar[XB_TOPGEN], 1u);
            else XB_SPIN(xb_ld(&bar[XB_TOPGEN]) == tg, bar);
            __builtin_amdgcn_fence(__ATOMIC_ACQUIRE, "agent");
            xb_add(&bar[XB_XGEN(b.x)], 1u);
            asm volatile("s_waitcnt vmcnt(0)" ::: "memory");
        } else {
            XB_SPIN(xb_ld(&bar[XB_XGEN(b.x)]) == gen, bar);
            __builtin_amdgcn_fence(__ATOMIC_ACQUIRE, "agent");
            asm volatile("s_waitcnt vmcnt(0)" ::: "memory");
        }
    }
    __syncthreads();
}

__device__ __forceinline__ void p0_transpose_item(const float* W, int K, int N, bf16* WT, int ldt, int rowmode, int hasScale, const float* scaleA, const float* scaleB  , LAS float* scr, int item, int lane) {
    const int nblk = N / 32, kb = item / nblk, nb = item % nblk, k0 = 64 * kb, n0 = 32 * nb;
#pragma unroll 8
    for (int i = 0; i < 32; ++i) { const int kk = 2 * i + (lane >> 5), k = k0 + kk; float s = 1.f; if (hasScale) s = (k < D) ? scaleA[k] : scaleB[k];
        scr[kk * 33 + (lane & 31)] = W[(size_t)k * N + n0 + (lane & 31)] * s; }
    LDS_WAIT(); asm volatile("" ::: "memory");
    const int c = lane & 7;
#pragma unroll
    for (int j = 0; j < 4; ++j) { const int n = (lane >> 3) + 8 * j; const LAS float* s = scr + (8 * c) * 33 + n; const int ng = n0 + n;
        const int dr = rowmode == 0 ? ng : ((ng >> 2) * 8 + (ng & 3) + (rowmode == 2 ? 4 : 0));
        v4u o; o.x = pk2(s[0 * 33], s[1 * 33]); o.y = pk2(s[2 * 33], s[3 * 33]); o.z = pk2(s[4 * 33], s[5 * 33]); o.w = pk2(s[6 * 33], s[7 * 33]);
        *(GAS v4u*)(WT + (size_t)dr * ldt + k0 + 8 * c) = o; }
    LDS_WAIT(); asm volatile("" ::: "memory");
}
__device__ __forceinline__ void p0_row(const Prm& p, int r, int lane) {
    const float* src = xsrc_row(p, r); bf16* XB = (bf16*)(p.ws + WS_XB); float* SQ0 = (float*)(p.ws + WS_SQ0);
    f32x4 v[4]; float s = 0.f;
#pragma unroll
    for (int j = 0; j < 4; ++j) { v[j] = src ? ((const GAS f32x4*)src)[lane + 64 * j] : (f32x4){0.f, 0.f, 0.f, 0.f}; s += (v[j].x * v[j].x + v[j].y * v[j].y) + (v[j].z * v[j].z + v[j].w * v[j].w); }
    s = wave_sum(s);
    GAS unsigned long long* o8 = (GAS unsigned long long*)(XB + (size_t)r * D) + lane;
#pragma unroll
    for (int j = 0; j < 4; ++j) o8[64 * j] = (unsigned long long)pk2(v[j].x, v[j].y) | ((unsigned long long)pk2(v[j].z, v[j].w) << 32);
    if (lane == 0) SQ0[r] = s;
}
__device__ __forceinline__ void p0_s5tables(const Prm& p, int i) {
    const int g = i / NP5, pp = i % NP5;
    const double lre = p.in[I_LRE][i], lim = p.in[I_LIM][i], dt = exp((double)p.in[I_LOGDT][g]);
    const double er = exp(lre * dt), lbr = er * cos(lim * dt), lbi = er * sin(lim * dt);
    const double e64 = exp(64.0 * lre * dt), l64r = e64 * cos(64.0 * lim * dt), l64i = e64 * sin(64.0 * lim * dt);
    float* LAMB = (float*)(p.ws + WS_LAMB); float* LAM64 = (float*)(p.ws + WS_LAM64);
    LAMB[2 * i] = (float)lbr; LAMB[2 * i + 1] = (float)lbi; LAM64[2 * i] = (float)l64r; LAM64[2 * i + 1] = (float)l64i;
    const double nr = lbr - 1.0, ni = lbi, dd = lre * lre + lim * lim;
    const double cr = (nr * lre + ni * lim) / dd, ci = (ni * lre - nr * lim) / dd;
    float* BBF = (float*)(p.ws + WS_BBF); bf16* BB = (bf16*)(p.ws + WS_BB); bf16* CMB = (bf16*)(p.ws + WS_CMB);
    for (int h = 0; h < NH5; ++h) {
        const double br = p.in[I_BRE][(size_t)i * NH5 + h], bi = p.in[I_BIM][(size_t)i * NH5 + h];
        const float xr = (float)(cr * br - ci * bi), xi = (float)(cr * bi + ci * br);
        BBF[((size_t)i * NH5 + h) * 2] = xr; BBF[((size_t)i * NH5 + h) * 2 + 1] = xi;
        BB[((size_t)g * 128 + pp) * 16 + h] = (bf16)f2bf(xr); BB[((size_t)g * 128 + 64 + pp) * 16 + h] = (bf16)f2bf(xi);
        const float c_re = p.in[I_CRE][((size_t)g * NH5 + h) * NP5 + pp], c_im = p.in[I_CIM][((size_t)g * NH5 + h) * NP5 + pp];
        CMB[((size_t)g * 16 + h) * 128 + pp] = (bf16)f2bf(c_re); CMB[((size_t)g * 16 + h) * 128 + 64 + pp] = (bf16)f2bf(-c_im);
    }
}
__device__ __forceinline__ void p0_prologue(const Prm& p, LAS unsigned char* lds, int vcu, int G, int wave, int lane) {
    LAS float* scr = (LAS float*)(lds + RING_OFF + wave * 16384);
    const int gw = vcu * NWAVES + wave, NGW = G * NWAVES;
    unsigned char* ws = p.ws;
    constexpr int I_GU = (D / 64) * (FF / 32), I_DN = (FF / 64) * (D / 32), I_IN = (D / 64) * (NPROJ / 32), I_GL = (D / 64) * (D / 32), I_WO = (2 * D / 64) * (D / 32);
    constexpr int NITEMS = 4 * I_GU + 2 * I_DN + I_IN + I_GL + I_WO;
    const float* ones = nullptr;
    for (int it = gw; it < NITEMS; it += NGW) {
        int r = it, mat = 0;
        if (r >= I_GU) { r -= I_GU; mat = 1; if (r >= I_GU) { r -= I_GU; mat = 2; if (r >= I_DN) { r -= I_DN; mat = 3; if (r >= I_IN) { r -= I_IN; mat = 4; if (r >= I_GL) { r -= I_GL; mat = 5;
            if (r >= I_WO) { r -= I_WO; mat = 6; if (r >= I_GU) { r -= I_GU; mat = 7; if (r >= I_GU) { r -= I_GU; mat = 8; } } } } } } } }
        const float* W; int K, N, ldt, rowmode, hasScale; size_t wsoff; const float* sA; const float* sB;
        switch (mat) {
            case 0: W = p.in[I_G1]; K = D; N = FF; wsoff = WS_W1GU; ldt = D; rowmode = 1; hasScale = 1; sA = p.in[I_NORM1]; sB = p.in[I_NORM1]; break;
            case 1: W = p.in[I_U1]; K = D; N = FF; wsoff = WS_W1GU; ldt = D; rowmode = 2; hasScale = 1; sA = p.in[I_NORM1]; sB = p.in[I_NORM1]; break;
            case 2: W = p.in[I_D1]; K = FF; N = D; wsoff = WS_W1D; ldt = FF; rowmode = 0; hasScale = 0; sA = p.in[I_NORM1]; sB = p.in[I_NORM1]; break;
            case 3: W = p.in[I_WIN]; K = D; N = NPROJ; wsoff = WS_WIN; ldt = D; rowmode = 0; hasScale = 1; sA = p.in[I_NORMMIX]; sB = p.in[I_NORMMIX]; break;
            case 4: W = p.in[I_GLUW]; K = D; N = D; wsoff = WS_WGLU; ldt = D; rowmode = 0; hasScale = 0; sA = p.in[I_NORM1]; sB = p.in[I_NORM1]; break;
            case 5: W = p.in[I_WOUT]; K = 2 * D; N = D; wsoff = WS_WOUT; ldt = 2 * D; rowmode = 0; hasScale = 1; sA = p.in[I_ONS5]; sB = p.in[I_ONML] - D; break;
            case 6: W = p.in[I_G2]; K = D; N = FF; wsoff = WS_W2GU; ldt = D; rowmode = 1; hasScale = 1; sA = p.in[I_NORM2]; sB = p.in[I_NORM2]; break;
            case 7: W = p.in[I_U2]; K = D; N = FF; wsoff = WS_W2GU; ldt = D; rowmode = 2; hasScale = 1; sA = p.in[I_NORM2]; sB = p.in[I_NORM2]; break;
            default: W = p.in[I_D2]; K = FF; N = D; wsoff = WS_W2D; ldt = FF; rowmode = 0; hasScale = 0; sA = p.in[I_NORM1]; sB = p.in[I_NORM1]; break;
        }
        (void)ones;
        p0_transpose_item(W, K, N, (bf16*)(ws + wsoff), ldt, rowmode, hasScale, sA, sB, scr, r, lane);
    }
    for (int m = gw; m < MR; m += NGW) p0_row(p, m, lane);
    const int gt = gw * 64 + lane, NGT = NGW * 64;
    for (int i = gt; i < NG5 * NP5; i += NGT) p0_s5tables(p, i);
    for (int i = gt; i < 16 * 3072; i += NGT) { const int row = i / 3072, c = i % 3072; float v = 0.f;
        if (row < 4) v = p.in[I_IGW][(size_t)c * 4 + row]; else if (row < 8) v = p.in[I_FGW][(size_t)c * 4 + row - 4];
        ((bf16*)(ws + WS_GWT))[i] = (bf16)f2bf(v); }
}
__device__ __forceinline__ void p_final(const Prm& p, int vcu, int G, int wave, int lane) {
    const int gw = vcu * NWAVES + wave, NGW = G * NWAVES; const float* SQ3 = (const float*)(p.ws + WS_SQ3); const GAS f32x4* nf = (const GAS f32x4*)p.in[I_NORMF];
    for (int r = gw; r < MR; r += NGW) {
        if (r < SROW0) { const int tp = r >= SLOT ? r - SLOT : r; if (tp < 256) continue; }
        GAS f32x4* xr = (GAS f32x4*)xrow(p, r); const float rs = rstd_of(SQ3[r]);
#pragma unroll
        for (int j = 0; j < 4; ++j) { const f32x4 v = xr[lane + 64 * j] * rs * nf[lane + 64 * j]; xr[lane + 64 * j] = v; }
    }
}
typedef float f32x16 __attribute__((ext_vector_type(16)));
typedef unsigned u32x2v __attribute__((ext_vector_type(2)));
constexpr int S5_BU_STRIDE = 132, S5_S_STRIDE = 136;
constexpr int S5_WAVE_LDS = 16 * S5_BU_STRIDE * 4 + 16 * S5_S_STRIDE * 2;
#define WAVE_LDS_SYNC() do { asm volatile("s_waitcnt lgkmcnt(0)" ::: "memory"); __builtin_amdgcn_wave_barrier(); } while (0)
template <bool PASS_C>
__device__ __forceinline__ void s5_wave_unit(const Prm& p, LAS unsigned char* wlds, int ch, int g, int lane) {
    unsigned char* ws = p.ws;
    bf16* U = (bf16*)(ws + WS_U); const bf16* BB = (const bf16*)(ws + WS_BB); const bf16* CMB = (const bf16*)(ws + WS_CMB);
    float* DS = (float*)(ws + WS_DS); const float* LAMB = (const float*)(ws + WS_LAMB);
    LAS float* BU = (LAS float*)wlds; LAS bf16* SS = (LAS bf16*)(wlds + 16 * S5_BU_STRIDE * 4);
    const int r0 = ch * 64, l31 = lane & 31, lh = lane >> 5, l15 = lane & 15, lq = lane >> 4;
    const bool sample = r0 >= SROW0;
    const float lr = LAMB[2 * (g * 64 + lane)], li = LAMB[2 * (g * 64 + lane) + 1];
    bf16x8 bfr[4], cfr[4];
#pragma unroll
    for (int ct = 0; ct < 4; ++ct) bfr[ct] = *(const bf16x8*)(BB + ((size_t)(g * 128 + 32 * ct + l31) * 16 + 8 * lh));
    if (PASS_C) {
#pragma unroll
        for (int ks = 0; ks < 4; ++ks) cfr[ks] = *(const bf16x8*)(CMB + ((size_t)(g * 16 + l15) * 128 + 32 * ks + 8 * lq));
    }
    f32x4 dsk = (f32x4){0.f, 0.f, 0.f, 0.f};
    if (PASS_C) dsk = *(const f32x4*)(p.in[I_S5D] + g * 16 + 4 * lq);
    float sr = 0.f, si = 0.f;
#pragma unroll 1
    for (int rt = 0; rt < 2; ++rt) {
        if (rt == 0 || sample) {
            if (PASS_C) {
                if (sample) { const int j = (r0 - SROW0) / TS + rt; sr = p.in[I_S5RE][((size_t)j * 64 + g) * 64 + lane]; si = p.in[I_S5IM][((size_t)j * 64 + g) * 64 + lane]; }
                else { const float2 v = *(const float2*)(DS + ((size_t)ch * 4096 + g * 64 + lane) * 2); sr = v.x; si = v.y; }
            } else { sr = 0.f; si = 0.f; }
        }
        const int rbase = r0 + 32 * rt;
        const bf16x8 afr = *(const bf16x8*)(U + (size_t)(rbase + l31) * D + g * 16 + 8 * lh);
        f32x16 acc[4];
#pragma unroll
        for (int ct = 0; ct < 4; ++ct) { f32x16 z; for (int i = 0; i < 16; ++i) z[i] = 0.f; acc[ct] = __builtin_amdgcn_mfma_f32_32x32x16_bf16(afr, bfr[ct], z, 0, 0, 0); }
#pragma unroll
        for (int hf = 0; hf < 2; ++hf) {
            WAVE_LDS_SYNC();
#pragma unroll
            for (int ct = 0; ct < 4; ++ct)
#pragma unroll
                for (int i = 0; i < 8; ++i) { const int tl = (i & 3) + 8 * (i >> 2) + 4 * lh; BU[tl * S5_BU_STRIDE + 32 * ct + l31] = acc[ct][8 * hf + i]; }
            WAVE_LDS_SYNC();
#pragma unroll
            for (int tl = 0; tl < 16; ++tl) {
                const float bre = BU[tl * S5_BU_STRIDE + lane], bim = BU[tl * S5_BU_STRIDE + 64 + lane];
                const float nr = lr * sr - li * si + bre, ni = lr * si + li * sr + bim; sr = nr; si = ni;
                if (PASS_C) { SS[tl * S5_S_STRIDE + lane] = (bf16)f2bf(sr); SS[tl * S5_S_STRIDE + 64 + lane] = (bf16)f2bf(si); }
            }
            if (PASS_C) {
                WAVE_LDS_SYNC();
                f32x4 y = (f32x4){0.f, 0.f, 0.f, 0.f};
#pragma unroll
                for (int ks = 0; ks < 4; ++ks) { const bf16x8 sfr = *(const LAS bf16x8*)(SS + l15 * S5_S_STRIDE + 32 * ks + 8 * lq); y = __builtin_amdgcn_mfma_f32_16x16x32_bf16(cfr[ks], sfr, y, 0, 0, 0); }
                bf16* up = U + (size_t)(rbase + 16 * hf + l15) * D + g * 16 + 4 * lq;
                const u32x2v uw = *(const u32x2v*)up;
                const float u0 = __uint_as_float(uw.x << 16), u1 = __uint_as_float(uw.x & 0xffff0000u), u2 = __uint_as_float(uw.y << 16), u3 = __uint_as_float(uw.y & 0xffff0000u);
                u32x2v ow; ow.x = pk2(geluf(y[0] + dsk[0] * u0), geluf(y[1] + dsk[1] * u1)); ow.y = pk2(geluf(y[2] + dsk[2] * u2), geluf(y[3] + dsk[3] * u3));
                *(u32x2v*)up = ow;
            }
        }
        if (rt == 1 || sample) {
            if (!PASS_C) { if (!sample) *(float2*)(DS + ((size_t)ch * 4096 + g * 64 + lane) * 2) = make_float2(sr, si); }
            else {
                if (sample) { const int j = (r0 - SROW0) / TS + rt; p.out[O_SS5R + ((size_t)j * 64 + g) * 64 + lane] = sr; p.out[O_SS5I + ((size_t)j * 64 + g) * 64 + lane] = si; }
                else if ((ch % (SLOT / 64)) == (SLOT / 64) - 1) { const int b = ch / (SLOT / 64); p.out[O_PS5R + ((size_t)b * 64 + g) * 64 + lane] = sr; p.out[O_PS5I + ((size_t)b * 64 + g) * 64 + lane] = si; }
            }
        }
    }
    WAVE_LDS_SYNC();
}
template <bool PASS_C>
__device__ __forceinline__ void s5_phase(const Prm& p, LAS unsigned char* lds, int blk, int nblk, int wave, int lane) {
    const int nch = PASS_C ? NCH64 : (NB * SLOT / 64);
    for (int uidx = blk; uidx < nch * 8; uidx += nblk) { const int ch = uidx >> 3, go = uidx & 7; s5_wave_unit<PASS_C>(p, lds + wave * S5_WAVE_LDS, ch, go * 8 + wave, lane); }
}
__device__ __forceinline__ void s5_scan(const Prm& p, int gtid, int ngt) {
    float2* DS = (float2*)(p.ws + WS_DS); const float2* LAM64 = (const float2*)(p.ws + WS_LAM64);
    constexpr int NC = SLOT / 64;
    for (int i = gtid; i < NB * 4096; i += ngt) {
        const int b = i >> 12, gp = i & 4095; const float2 l = LAM64[gp]; float sr = 0.f, si = 0.f;
        float2* base = DS + (size_t)b * NC * 4096 + gp;
#pragma unroll 1
        for (int c0 = 0; c0 < NC; c0 += 12) {
            float2 v[12];
#pragma unroll
            for (int k = 0; k < 12; ++k) v[k] = base[(size_t)(c0 + k) * 4096];
#pragma unroll
            for (int k = 0; k < 12; ++k) { base[(size_t)(c0 + k) * 4096] = make_float2(sr, si); const float nr = l.x * sr - l.y * si + v[k].x, ni = l.x * si + l.y * sr + v[k].y; sr = nr; si = ni; }
        }
    }
}
typedef unsigned u32x4v __attribute__((ext_vector_type(4)));
__device__ __forceinline__ float bflo(unsigned w) { return __uint_as_float(w << 16); }
__device__ __forceinline__ float bfhi(unsigned w) { return __uint_as_float(w & 0xffff0000u); }
__device__ __forceinline__ void xm4_at(const Prm& p, const bf16* XM, int r, int back, int ch4, float (&o)[4]) {
    bool fromx = true; const float* cs = nullptr;
    if (r >= SROW0) { const int j = (r - SROW0) / TS, t = (r - SROW0) % TS - back; if (t < 0) { fromx = false; cs = p.in[I_MLCONV] + ((size_t)j * 3 + (3 + t)) * D + ch4; } }
    else { const int tp = (r >= SLOT ? r - SLOT : r) - back; if (tp < 0) fromx = false; }
    if (fromx) { const u32x2v w = *(const u32x2v*)(XM + (size_t)(r - back) * D + ch4); o[0] = bflo(w.x); o[1] = bfhi(w.x); o[2] = bflo(w.y); o[3] = bfhi(w.y); }
    else if (cs) { const f32x4 v = *(const f32x4*)cs; o[0] = v[0]; o[1] = v[1]; o[2] = v[2]; o[3] = v[3]; }
    else { o[0] = o[1] = o[2] = o[3] = 0.f; }
}
constexpr int PG_STRIDE = 2056;
constexpr int PG_TILE_BYTES = 70 * PG_STRIDE;
__device__ __forceinline__ void pg_unit(const Prm& p, LAS unsigned char* lds, int rb, int tid, int wave, int lane) {
    unsigned char* ws = p.ws; const bf16* XM = (const bf16*)(ws + WS_XM); bf16* KB = (bf16*)(ws + WS_XB);
    float* IG = (float*)(ws + WS_IG); float* LF = (float*)(ws + WS_LF);
    const int r0 = rb * 64; const bool sample = r0 >= SROW0;
    for (int c = tid; c < 70 * 256; c += NWAVES * 64) {
        const int tr = c >> 8, pc = c & 255; float v[4];
        if (tr < 64) xm4_at(p, XM, r0 + tr, 0, 4 * pc, v);
        else if (tr < 67) xm4_at(p, XM, r0, 67 - tr, 4 * pc, v);
        else { if (sample) xm4_at(p, XM, r0 + 32, 70 - tr, 4 * pc, v); else { v[0] = v[1] = v[2] = v[3] = 0.f; } }
        u32x2v w; w.x = pk2(v[0], v[1]); w.y = pk2(v[2], v[3]);
        *(LAS u32x2v*)(lds + tr * PG_STRIDE + pc * 8) = w;
    }
    __syncthreads();
    const int i = lane; int prow[3];
#pragma unroll
    for (int b = 1; b <= 3; ++b) { const int s0 = (sample && i >= 32) ? 32 : 0; const int j = i - b; prow[b - 1] = (j >= s0) ? j : ((s0 == 0 ? 64 : 67) + (j - s0 + 3)); }
    float ga[8];
#pragma unroll
    for (int h = 0; h < 8; ++h) ga[h] = 0.f;
    const float* cw = p.in[I_CONVW]; const float* cb = p.in[I_CONVB]; const float* wq = p.in[I_WQ]; const float* wk = p.in[I_WK]; const float* wv = p.in[I_WV];
    const float* igw = p.in[I_IGW]; const float* fgw = p.in[I_FGW];
#pragma unroll 1
    for (int bb = 0; bb < 32; ++bb) {
        const int blk = wave * 32 + bb, ch = 4 * blk;
        LAS unsigned char* colp = lds + ch * 2;
        const u32x2v w3 = *(const LAS u32x2v*)(colp + i * PG_STRIDE), w2 = *(const LAS u32x2v*)(colp + prow[0] * PG_STRIDE), w1 = *(const LAS u32x2v*)(colp + prow[1] * PG_STRIDE), w0 = *(const LAS u32x2v*)(colp + prow[2] * PG_STRIDE);
        const float x3[4] = {bflo(w3.x), bfhi(w3.x), bflo(w3.y), bfhi(w3.y)}, x2[4] = {bflo(w2.x), bfhi(w2.x), bflo(w2.y), bfhi(w2.y)};
        const float x1[4] = {bflo(w1.x), bfhi(w1.x), bflo(w1.y), bfhi(w1.y)}, x0[4] = {bflo(w0.x), bfhi(w0.x), bflo(w0.y), bfhi(w0.y)};
        float xc[4];
#pragma unroll
        for (int e = 0; e < 4; ++e) xc[e] = siluf(cb[ch + e] + cw[ch + e] * x0[e] + cw[D + ch + e] * x1[e] + cw[2 * D + ch + e] * x2[e] + cw[3 * D + ch + e] * x3[e]);
        float kk[4];
#pragma unroll
        for (int o = 0; o < 4; ++o) { float q = 0.f, k = 0.f, v = 0.f;
#pragma unroll
            for (int e = 0; e < 4; ++e) { q += xc[e] * wq[(blk * 4 + e) * 4 + o]; k += xc[e] * wk[(blk * 4 + e) * 4 + o]; v += x3[e] * wv[(blk * 4 + e) * 4 + o]; }
            kk[o] = k; const int c = ch + o;
#pragma unroll
            for (int h = 0; h < 4; ++h) { ga[h] += q * igw[c * 4 + h] + k * igw[(1024 + c) * 4 + h] + v * igw[(2048 + c) * 4 + h];
                                          ga[4 + h] += q * fgw[c * 4 + h] + k * fgw[(1024 + c) * 4 + h] + v * fgw[(2048 + c) * 4 + h]; } }
        u32x2v kw; kw.x = pk2(kk[0] * 0.0625f, kk[1] * 0.0625f); kw.y = pk2(kk[2] * 0.0625f, kk[3] * 0.0625f);
        *(LAS u32x2v*)(colp + i * PG_STRIDE) = kw;
    }
    __syncthreads();
    for (int c = tid; c < 64 * 256; c += NWAVES * 64) { const int tr = c >> 8, pc = c & 255; *(u32x2v*)(KB + (size_t)(r0 + tr) * D + 4 * pc) = *(const LAS u32x2v*)(lds + tr * PG_STRIDE + pc * 8); }
    __syncthreads();
    LAS float* red = (LAS float*)lds;
#pragma unroll
    for (int h = 0; h < 8; ++h) red[(wave * 64 + i) * 8 + h] = ga[h];
    __syncthreads();
    { const int row = tid & 63, h = tid >> 6; float s = 0.f;
#pragma unroll
      for (int w = 0; w < 8; ++w) s += red[(w * 64 + row) * 8 + h];
      const int r = r0 + row; const bool pad = row_is_pad(r);
      if (h < 4) IG[(size_t)r * 4 + h] = pad ? -1e30f : s + p.in[I_IGB][h]; else LF[(size_t)r * 4 + h - 4] = pad ? 0.f : logsigf(s + p.in[I_FGB][h - 4]); }
    __syncthreads();
}
__device__ __forceinline__ void convout_items(const Prm& p, int gtid, int ngt) {
    const bf16* XM = (const bf16*)(p.ws + WS_XM);
    for (int i = gtid; i < NB * 3 * D + NSTR * 3 * D; i += ngt) {
        if (i < NB * 3 * D) { const int b = i / (3 * D), j = (i / D) % 3, c = i % D; p.out[O_PCONV + i] = bf2f(XM[(size_t)(b * SLOT + SLOT - 3 + j) * D + c]); }
        else { const int k = i - NB * 3 * D; const int s = k / (3 * D), j = (k / D) % 3, c = k % D; p.out[O_SCONV + k] = bf2f(XM[(size_t)(SROW0 + s * TS + TS - 3 + j) * D + c]); }
    }
}
constexpr int KT_STRIDE = 72;
constexpr int PM_KT_OFF = 0, PM_VT_OFF = 256 * KT_STRIDE * 2  , PM_W_OFF = PM_VT_OFF + 128 * KT_STRIDE * 2  , PM_RED_OFF = PM_W_OFF + 1024;
__device__ __forceinline__ int crow32(int reg, int lh) { return (reg & 3) + 8 * (reg >> 2) + 4 * lh; }
__device__ __forceinline__ void seg_rows(int seg, int& row0, int& L) { if (seg < NB * (SLOT / 256)) { row0 = seg * 256; L = 256; } else { row0 = SROW0 + (seg - NB * (SLOT / 256)) * TS; L = TS; } }
__device__ __forceinline__ void pm_unit(const Prm& p, LAS unsigned char* lds, int unit, int tid, int wave, int lane) {
    unsigned char* ws = p.ws; const bf16* XM = (const bf16*)(ws + WS_XM); const bf16* KB = (const bf16*)(ws + WS_XB);
    const float* IG = (const float*)(ws + WS_IG); const float* LF = (const float*)(ws + WS_LF);
    float* BC = (float*)(ws + WS_BC); float* AA = (float*)(ws + WS_AA); float* AM = (float*)(ws + WS_AM);
    bf16* CS = (bf16*)(ws + WS_CS); float* NS = (float*)(ws + WS_NS); float* SEGS = (float*)(ws + WS_SEGS);
    const int vh = unit & 1, hd = (unit >> 1) & 3, seg = unit >> 3; int row0, L; seg_rows(seg, row0, L);
    LAS bf16* Kt = (LAS bf16*)(lds + PM_KT_OFF); LAS bf16* Vt = (LAS bf16*)(lds + PM_VT_OFF); LAS float* wL = (LAS float*)(lds + PM_W_OFF); LAS float* red = (LAS float*)(lds + PM_RED_OFF);
    if (wave == 0) {
        const int cnt = L / 64 > 0 ? L / 64 : 1; const bool act = (L >= 64) || lane < L;
        float lf[4], ig[4], bc[4], av[4], am[4]; float ls = 0.f;
#pragma unroll
        for (int k = 0; k < 4; ++k) { const bool on = act && k < cnt; const int r = row0 + cnt * lane + k; lf[k] = on ? LF[(size_t)r * 4 + hd] : 0.f; ig[k] = on ? IG[(size_t)r * 4 + hd] : -1e30f; ls += lf[k]; bc[k] = ls; }
        float pre = ls;
#pragma unroll
        for (int o = 1; o < 64; o <<= 1) { const float t = __shfl_up(pre, o); if (lane >= o) pre += t; }
        const float excl = pre - ls; float lm = -3e38f;
#pragma unroll
        for (int k = 0; k < 4; ++k) { bc[k] += excl; av[k] = ig[k] - bc[k]; if (!(act && k < cnt)) av[k] = -1e30f; lm = fmaxf(lm, av[k]); am[k] = lm; }
        float pm = lm;
#pragma unroll
        for (int o = 1; o < 64; o <<= 1) { const float t = __shfl_up(pm, o); if (lane >= o) pm = fmaxf(pm, t); }
        float pex = __shfl_up(pm, 1); if (lane == 0) pex = -3e38f;
        const float AT = __shfl(pm, 63), BT = __shfl(pre, 63);
#pragma unroll
        for (int k = 0; k < 4; ++k) { am[k] = fmaxf(am[k], pex);
            if (act && k < cnt) { const int tl = cnt * lane + k; const int r = row0 + tl;
                wL[tl] = (AT > -1e29f) ? __expf(av[k] - AT) : 0.f;
                if (vh == 0) { BC[(size_t)r * 4 + hd] = bc[k]; AA[(size_t)r * 4 + hd] = av[k]; AM[(size_t)r * 4 + hd] = am[k]; } } }
        if (vh == 0 && lane == 0) { SEGS[(seg * 4 + hd) * 4 + 0] = AT; SEGS[(seg * 4 + hd) * 4 + 1] = BT; }
    }
    __syncthreads();
    const int l31 = lane & 31, lh = lane >> 5, wv4 = wave & 3, wk = wave >> 2;
    f32x16 acc[4];
#pragma unroll
    for (int ct = 0; ct < 4; ++ct) for (int i = 0; i < 16; ++i) acc[ct][i] = 0.f;
    float dn = 0.f;
    const int nsb = (L + 63) / 64, ntok = L < 64 ? L : 64;
    const float* wvp = p.in[I_WV];
#pragma unroll 1
    for (int sb = 0; sb < nsb; ++sb) {
        const int rs = row0 + sb * 64;
        for (int c = tid; c < 64 * 32; c += NWAVES * 64) { const int s = c & 63, kc = c >> 6;
            if (s < ntok) { const u32x4v w = *(const u32x4v*)(KB + (size_t)(rs + s) * D + hd * 256 + 8 * kc); LAS bf16* d = Kt + (8 * kc) * KT_STRIDE + s;
                d[0] = (bf16)(w.x & 0xffffu); d[KT_STRIDE] = (bf16)(w.x >> 16); d[2 * KT_STRIDE] = (bf16)(w.y & 0xffffu); d[3 * KT_STRIDE] = (bf16)(w.y >> 16);
                d[4 * KT_STRIDE] = (bf16)(w.z & 0xffffu); d[5 * KT_STRIDE] = (bf16)(w.z >> 16); d[6 * KT_STRIDE] = (bf16)(w.w & 0xffffu); d[7 * KT_STRIDE] = (bf16)(w.w >> 16); } }
        for (int c = tid; c < 64 * 32; c += NWAVES * 64) { const int s = c & 63, bq = c >> 6, gb = hd * 64 + vh * 32 + bq;
            if (s < ntok) { const u32x2v xw = *(const u32x2v*)(XM + (size_t)(rs + s) * D + 4 * gb); const float x[4] = {bflo(xw.x), bfhi(xw.x), bflo(xw.y), bfhi(xw.y)}; const float wsc = wL[sb * 64 + s];
#pragma unroll
                for (int o = 0; o < 4; ++o) { float v = 0.f;
#pragma unroll
                    for (int e = 0; e < 4; ++e) v += x[e] * wvp[(gb * 4 + e) * 4 + o];
                    Vt[(4 * bq + o) * KT_STRIDE + s] = (bf16)f2bf(v * wsc); } } }
        __syncthreads();
        const int nks = ntok / 16;
        for (int ks = 0; ks < nks; ++ks) {
            const bf16x8 bfr = *(const LAS bf16x8*)(Vt + (32 * wv4 + l31) * KT_STRIDE + 16 * ks + 8 * lh);
#pragma unroll
            for (int ct = 0; ct < 4; ++ct) { const bf16x8 afr = *(const LAS bf16x8*)(Kt + (128 * wk + 32 * ct + l31) * KT_STRIDE + 16 * ks + 8 * lh);
                acc[ct] = __builtin_amdgcn_mfma_f32_32x32x16_bf16(afr, bfr, acc[ct], 0, 0, 0); }
        }
        if (vh == 0) { const int kd = tid & 255, hf = tid >> 8; const int s0 = hf * (ntok / 2);
            for (int s = s0; s < s0 + ntok / 2; ++s) dn += bf2f(Kt[kd * KT_STRIDE + s]) * wL[sb * 64 + s]; }
        __syncthreads();
    }
    { bf16* cbase = CS + ((size_t)(seg * 4 + hd) * 256 + (128 * vh + 32 * wv4 + l31)) * 256 + 128 * wk + 4 * lh;
#pragma unroll
      for (int ct = 0; ct < 4; ++ct)
#pragma unroll
          for (int q = 0; q < 4; ++q) { u32x2v w; w.x = pk2(acc[ct][4 * q], acc[ct][4 * q + 1]); w.y = pk2(acc[ct][4 * q + 2], acc[ct][4 * q + 3]); *(u32x2v*)(cbase + 32 * ct + 8 * q) = w; } }
    if (vh == 0) { const int kd = tid & 255, hf = tid >> 8; if (hf == 1) red[kd] = dn; __syncthreads(); if (hf == 0) NS[(size_t)(seg * 4 + hd) * 256 + kd] = dn + red[kd]; }
    __syncthreads();
}
__device__ __forceinline__ void ps_scan(const Prm& p, int gtid, int ngt) {
    unsigned char* ws = p.ws; bf16* CS = (bf16*)(ws + WS_CS); float* NS = (float*)(ws + WS_NS); float* SEGS = (float*)(ws + WS_SEGS);
    constexpr int NC = SLOT / 256;
    for (int i = gtid; i < NB * 4 * 16384; i += ngt) {
        const int q = i & 16383, hd = (i >> 14) & 3, b = i >> 16; float c0 = 0.f, c1 = 0.f, c2 = 0.f, c3 = 0.f, m = 0.f;
#pragma unroll 3
        for (int c = 0; c < NC; ++c) { const int seg = b * NC + c; const float AT = SEGS[(seg * 4 + hd) * 4], BT = SEGS[(seg * 4 + hd) * 4 + 1];
            u32x2v* ptr = (u32x2v*)(CS + (size_t)(seg * 4 + hd) * 65536) + q; const u32x2v d = *ptr;
            u32x2v o; o.x = pk2(c0, c1); o.y = pk2(c2, c3); *ptr = o;
            const float mu = fmaxf(m, AT), e1 = __expf(m - mu), e2 = __expf(AT - mu);
            c0 = e1 * c0 + e2 * bflo(d.x); c1 = e1 * c1 + e2 * bfhi(d.x); c2 = e1 * c2 + e2 * bflo(d.y); c3 = e1 * c3 + e2 * bfhi(d.y); m = BT + mu; }
        *(f32x4*)(p.out + O_PC + ((size_t)(b * 4 + hd) * 16384 + q) * 4) = (f32x4){c0, c1, c2, c3};
    }
    for (int i = gtid; i < NB * 4 * 256; i += ngt) {
        const int kd = i & 255, hd = (i >> 8) & 3, b = i >> 10; float n = 0.f, m = 0.f;
        for (int c = 0; c < NC; ++c) { const int seg = b * NC + c; const float AT = SEGS[(seg * 4 + hd) * 4], BT = SEGS[(seg * 4 + hd) * 4 + 1];
            float* ptr = NS + (size_t)(seg * 4 + hd) * 256 + kd; const float d = *ptr; *ptr = n; if (kd == 0) SEGS[(seg * 4 + hd) * 4 + 2] = m;
            const float mu = fmaxf(m, AT); n = __expf(m - mu) * n + __expf(AT - mu) * d; m = BT + mu; }
        p.out[O_PN + (size_t)(b * 4 + hd) * 256 + kd] = n; if (kd == 0) p.out[O_PM + b * 4 + hd] = m;
    }
    for (int i = gtid; i < NSTR * 4 * 16384; i += ngt) {
        const int q = i & 16383, hd = (i >> 14) & 3, j = i >> 16, seg = NB * NC + j; const float AT = SEGS[(seg * 4 + hd) * 4];
        const float m = p.in[I_MLM][j * 4 + hd], mu = fmaxf(m, AT), e1 = __expf(m - mu), e2 = __expf(AT - mu);
        const f32x4 c0 = *(const f32x4*)(p.in[I_MLC] + ((size_t)(j * 4 + hd) * 16384 + q) * 4);
        u32x2v* ptr = (u32x2v*)(CS + (size_t)(seg * 4 + hd) * 65536) + q; const u32x2v d = *ptr;
        u32x2v o; o.x = pk2(c0[0], c0[1]); o.y = pk2(c0[2], c0[3]); *ptr = o;
        *(f32x4*)(p.out + O_SC + ((size_t)(j * 4 + hd) * 16384 + q) * 4) = (f32x4){e1 * c0[0] + e2 * bflo(d.x), e1 * c0[1] + e2 * bfhi(d.x), e1 * c0[2] + e2 * bflo(d.y), e1 * c0[3] + e2 * bfhi(d.y)};
    }
    for (int i = gtid; i < NSTR * 4 * 256; i += ngt) {
        const int kd = i & 255, hd = (i >> 8) & 3, j = i >> 10, seg = NB * NC + j; const float AT = SEGS[(seg * 4 + hd) * 4], BT = SEGS[(seg * 4 + hd) * 4 + 1];
        const float m = p.in[I_MLM][j * 4 + hd], mu = fmaxf(m, AT); const float n0 = p.in[I_MLN][(size_t)(j * 4 + hd) * 256 + kd];
        float* ptr = NS + (size_t)(seg * 4 + hd) * 256 + kd; const float d = *ptr; *ptr = n0;
        p.out[O_SN + (size_t)(j * 4 + hd) * 256 + kd] = __expf(m - mu) * n0 + __expf(AT - mu) * d;
        if (kd == 0) { SEGS[(seg * 4 + hd) * 4 + 2] = m; p.out[O_SM + j * 4 + hd] = BT + mu; }
    }
}
__device__ __forceinline__ void lds_addf(LAS float* q, float v) { (void)__hip_atomic_fetch_add(q, v, __ATOMIC_RELAXED, __HIP_MEMORY_SCOPE_WORKGROUP); }
constexpr int QS_STRIDE = 264;
constexpr int PO_Q_OFF = 0, PO_K_OFF = 64 * QS_STRIDE * 2  , PO_VT_OFF = 2 * PO_K_OFF  , PO_P_OFF = PO_VT_OFF + 256 * KT_STRIDE * 2  , PO_SC_OFF = PO_P_OFF + 64 * KT_STRIDE * 2  ;
__device__ __forceinline__ void po_unit(const Prm& p, LAS unsigned char* lds, int unit, int tid, int wave, int lane) {
    unsigned char* ws = p.ws; const bf16* XM = (const bf16*)(ws + WS_XM); const bf16* KB = (const bf16*)(ws + WS_XB); bf16* ZB = (bf16*)(ws + WS_Z);
    const float* BC = (const float*)(ws + WS_BC); const float* AA = (const float*)(ws + WS_AA); const float* AM = (const float*)(ws + WS_AM);
    const bf16* CS = (const bf16*)(ws + WS_CS); const float* NS = (const float*)(ws + WS_NS); const float* SEGS = (const float*)(ws + WS_SEGS); float* SQM = (float*)(ws + WS_SQM);
    const int hd = unit & 3, rb = unit >> 2, r0 = rb * 64; const bool sample = r0 >= SROW0;
    LAS bf16* Qs = (LAS bf16*)(lds + PO_Q_OFF); LAS bf16* Ks = (LAS bf16*)(lds + PO_K_OFF); LAS bf16* Vt = (LAS bf16*)(lds + PO_VT_OFF); LAS bf16* Ps = (LAS bf16*)(lds + PO_P_OFF);
    LAS float* sc = (LAS float*)(lds + PO_SC_OFF);
    LAS float* s_mu = sc, *s_ai = sc + 64, *s_emt = sc + 128, *s_as = sc + 192, *s_den = sc + 256, *s_dnq = sc + 320, *s_hs = sc + 384, *s_hq = sc + 448;
    const int l31 = lane & 31, lh = lane >> 5, l15 = lane & 15, lq = lane >> 4;
    const int seg0 = sample ? NB * (SLOT / 256) + (r0 - SROW0) / TS : r0 / 256, seg1 = sample ? seg0 + 1 : seg0;
    const int qi = sample ? 0 : (r0 & 255) >> 6;
    if (tid < 64) { const int t = tid, row = r0 + t, seg = t < 32 ? seg0 : seg1; const float mp = SEGS[(seg * 4 + hd) * 4 + 2];
        const float mu = fmaxf(mp, AM[(size_t)row * 4 + hd]); s_mu[t] = mu; s_ai[t] = __expf(mp - mu); s_emt[t] = __expf(-BC[(size_t)row * 4 + hd] - mu);
        s_den[t] = 0.f; s_dnq[t] = 0.f; s_hs[t] = 0.f; s_hq[t] = 0.f; }
    { const float* cw = p.in[I_CONVW]; const float* cb = p.in[I_CONVB]; const float* wq = p.in[I_WQ];
      for (int c = tid; c < 64 * 64; c += NWAVES * 64) { const int t = c & 63, bq = c >> 6, gb = hd * 64 + bq, ch = 4 * gb; float x0[4], x1[4], x2[4], x3[4];
          xm4_at(p, XM, r0 + t, 3, ch, x0); xm4_at(p, XM, r0 + t, 2, ch, x1); xm4_at(p, XM, r0 + t, 1, ch, x2); xm4_at(p, XM, r0 + t, 0, ch, x3);
          float xc[4], q[4];
#pragma unroll
          for (int e = 0; e < 4; ++e) xc[e] = siluf(cb[ch + e] + cw[ch + e] * x0[e] + cw[D + ch + e] * x1[e] + cw[2 * D + ch + e] * x2[e] + cw[3 * D + ch + e] * x3[e]);
#pragma unroll
          for (int o = 0; o < 4; ++o) { q[o] = 0.f;
#pragma unroll
              for (int e = 0; e < 4; ++e) q[o] += xc[e] * wq[(gb * 4 + e) * 4 + o]; }
          u32x2v w; w.x = pk2(q[0], q[1]); w.y = pk2(q[2], q[3]); *(LAS u32x2v*)(Qs + t * QS_STRIDE + 4 * bq) = w; } }
    __syncthreads();
    { const int t = tid & 63, part = tid >> 6, seg = t < 32 ? seg0 : seg1; const float* np = NS + (size_t)(seg * 4 + hd) * 256 + 32 * part; float s = 0.f;
#pragma unroll 8
      for (int d = 0; d < 32; ++d) s += np[d] * bf2f(Qs[t * QS_STRIDE + 32 * part + d]);
      lds_addf(&s_dnq[t], s); }
    f32x16 acc[2];
#pragma unroll
    for (int ct = 0; ct < 2; ++ct) for (int i = 0; i < 16; ++i) acc[ct][i] = 0.f;
    { const bf16* c0p = CS + ((size_t)(seg0 * 4 + hd) * 256 + 32 * wave + l31) * 256 + 8 * lh; const bf16* c1p = CS + ((size_t)(seg1 * 4 + hd) * 256 + 32 * wave + l31) * 256 + 8 * lh;
#pragma unroll 4
      for (int ks = 0; ks < 16; ++ks) {
          const bf16x8 a0 = *(const bf16x8*)(c0p + 16 * ks); const bf16x8 a1 = sample ? *(const bf16x8*)(c1p + 16 * ks) : a0;
          const bf16x8 b0 = *(const LAS bf16x8*)(Qs + l31 * QS_STRIDE + 16 * ks + 8 * lh), b1 = *(const LAS bf16x8*)(Qs + (32 + l31) * QS_STRIDE + 16 * ks + 8 * lh);
          acc[0] = __builtin_amdgcn_mfma_f32_32x32x16_bf16(a0, b0, acc[0], 0, 0, 0); acc[1] = __builtin_amdgcn_mfma_f32_32x32x16_bf16(a1, b1, acc[1], 0, 0, 0); }
      const float ai0 = s_ai[l31], ai1 = s_ai[32 + l31];
#pragma unroll
      for (int i = 0; i < 16; ++i) { acc[0][i] *= ai0; acc[1][i] *= ai1; } }
    const int nj = sample ? 1 : qi + 1; const float* wvp = p.in[I_WV];
#pragma unroll 1
    for (int j = 0; j < nj; ++j) {
        const int k0 = sample ? r0 : (r0 - 64 * qi + 64 * j); const bool diag = sample || (j == qi);
        __syncthreads();
        for (int c = tid; c < 64 * 32; c += NWAVES * 64) { const int s = c >> 5, kc = c & 31; *(LAS u32x4v*)(Ks + s * QS_STRIDE + 8 * kc) = *(const u32x4v*)(KB + (size_t)(k0 + s) * D + hd * 256 + 8 * kc); }
        for (int c = tid; c < 64 * 64; c += NWAVES * 64) { const int s = c & 63, bq = c >> 6, gb = hd * 64 + bq;
            const u32x2v xw = *(const u32x2v*)(XM + (size_t)(k0 + s) * D + 4 * gb); const float x[4] = {bflo(xw.x), bfhi(xw.x), bflo(xw.y), bfhi(xw.y)};
#pragma unroll
            for (int o = 0; o < 4; ++o) { float v = 0.f;
#pragma unroll
                for (int e = 0; e < 4; ++e) v += x[e] * wvp[(gb * 4 + e) * 4 + o];
                Vt[(4 * bq + o) * KT_STRIDE + s] = (bf16)f2bf(v); } }
        if (tid < 64) s_as[tid] = AA[(size_t)(k0 + tid) * 4 + hd];
        __syncthreads();
        { const int tt = wave & 3; f32x4 sa[2];
          sa[0] = (f32x4){0.f, 0.f, 0.f, 0.f}; sa[1] = sa[0];
#pragma unroll
          for (int ks = 0; ks < 8; ++ks) { const bf16x8 qf = *(const LAS bf16x8*)(Qs + (16 * tt + l15) * QS_STRIDE + 32 * ks + 8 * lq);
#pragma unroll
              for (int z = 0; z < 2; ++z) { const int st = 2 * (wave >> 2) + z; const bf16x8 kf = *(const LAS bf16x8*)(Ks + (16 * st + l15) * QS_STRIDE + 32 * ks + 8 * lq);
                  sa[z] = __builtin_amdgcn_mfma_f32_16x16x32_bf16(kf, qf, sa[z], 0, 0, 0); } }
          const int t = 16 * tt + l15; const float mu = s_mu[t];
#pragma unroll
          for (int z = 0; z < 2; ++z) { const int st = 2 * (wave >> 2) + z; float pv[4]; float ds = 0.f;
#pragma unroll
              for (int i = 0; i < 4; ++i) { const int s = 16 * st + 4 * lq + i; bool ok = true; if (diag) ok = (s <= t) && (!sample || ((s >> 5) == (t >> 5)));
                  pv[i] = ok ? sa[z][i] * __expf(s_as[s] - mu) : 0.f; ds += pv[i]; }
              u32x2v w; w.x = pk2(pv[0], pv[1]); w.y = pk2(pv[2], pv[3]); *(LAS u32x2v*)(Ps + t * KT_STRIDE + 16 * st + 4 * lq) = w;
              ds += __shfl_xor(ds, 16); ds += __shfl_xor(ds, 32);
              if (lq == 0) lds_addf(&s_den[t], ds); } }
        __syncthreads();
#pragma unroll
        for (int ks = 0; ks < 4; ++ks) { const bf16x8 vf = *(const LAS bf16x8*)(Vt + (32 * wave + l31) * KT_STRIDE + 16 * ks + 8 * lh);
            const bf16x8 p0 = *(const LAS bf16x8*)(Ps + l31 * KT_STRIDE + 16 * ks + 8 * lh), p1 = *(const LAS bf16x8*)(Ps + (32 + l31) * KT_STRIDE + 16 * ks + 8 * lh);
            acc[0] = __builtin_amdgcn_mfma_f32_32x32x16_bf16(vf, p0, acc[0], 0, 0, 0); acc[1] = __builtin_amdgcn_mfma_f32_32x32x16_bf16(vf, p1, acc[1], 0, 0, 0); }
    }
    __syncthreads();
    LAS bf16* Hs = Ks;
#pragma unroll
    for (int ct = 0; ct < 2; ++ct) { const int t = 32 * ct + l31; const float den = s_ai[t] * s_dnq[t] + s_den[t]; const float inv = 1.f / fmaxf(fabsf(den), s_emt[t]); float s1 = 0.f, s2 = 0.f;
#pragma unroll
        for (int q = 0; q < 4; ++q) { float h[4];
#pragma unroll
            for (int i = 0; i < 4; ++i) { h[i] = acc[ct][4 * q + i] * inv; s1 += h[i]; s2 += h[i] * h[i]; }
            u32x2v w; w.x = pk2(h[0], h[1]); w.y = pk2(h[2], h[3]); *(LAS u32x2v*)(Hs + t * QS_STRIDE + 32 * wave + 8 * q + 4 * lh) = w; }
        s1 += __shfl_xor(s1, 32); s2 += __shfl_xor(s2, 32);
        if (lh == 0) { lds_addf(&s_hs[t], s1); lds_addf(&s_hq[t], s2); } }
    __syncthreads();
    { const float* cw = p.in[I_CONVW]; const float* cb = p.in[I_CONVB];
      for (int c = tid; c < 64 * 32; c += NWAVES * 64) { const int vc = c & 31, t = c >> 5, row = r0 + t, ch = hd * 256 + 8 * vc;
          const float mean = s_hs[t] * (1.f / 256.f), var = fmaxf(s_hq[t] * (1.f / 256.f) - mean * mean, 0.f), rstd = rsqrtf(var + EPS);
          const u32x4v hw = *(const LAS u32x4v*)(Hs + t * QS_STRIDE + 8 * vc); const u32x4v zw = *(const u32x4v*)(ZB + (size_t)row * D + ch);
          float xa[4][8];
#pragma unroll
          for (int bk = 0; bk < 4; ++bk) { float lo[4], hi[4]; xm4_at(p, XM, row, 3 - bk, ch, lo); xm4_at(p, XM, row, 3 - bk, ch + 4, hi);
#pragma unroll
              for (int e = 0; e < 4; ++e) { xa[bk][e] = lo[e]; xa[bk][4 + e] = hi[e]; } }
          float o[8]; float ss = 0.f;
#pragma unroll
          for (int e = 0; e < 8; ++e) { const unsigned hwd = e < 2 ? hw.x : (e < 4 ? hw.y : (e < 6 ? hw.z : hw.w)), zwd = e < 2 ? zw.x : (e < 4 ? zw.y : (e < 6 ? zw.z : zw.w));
              const float h = (e & 1) ? bfhi(hwd) : bflo(hwd), z = (e & 1) ? bfhi(zwd) : bflo(zwd);
              const float xc = siluf(cb[ch + e] + cw[ch + e] * xa[0][e] + cw[D + ch + e] * xa[1][e] + cw[2 * D + ch + e] * xa[2][e] + cw[3 * D + ch + e] * xa[3][e]);
              const float hn = (h - mean) * rstd * p.in[I_MLNORM][ch + e]; o[e] = (hn + p.in[I_SKIP][ch + e] * xc) * siluf(z); ss += o[e] * o[e]; }
          u32x4v ow; ow.x = pk2(o[0], o[1]); ow.y = pk2(o[2], o[3]); ow.z = pk2(o[4], o[5]); ow.w = pk2(o[6], o[7]); *(u32x4v*)(ZB + (size_t)row * D + ch) = ow;
          ss += __shfl_xor(ss, 1); ss += __shfl_xor(ss, 2); ss += __shfl_xor(ss, 4); ss += __shfl_xor(ss, 8); ss += __shfl_xor(ss, 16);
          if (vc == 0) atomicAdd(SQM + row, ss); } }
    __syncthreads();
}
#define MIXER_PHASES \
    if (IN(PH_MG)) { for (int u = bx; u < MR / 64; u += G) pg_unit(p, lds, u, tid, wave, lane); \
                     s5_phase<false>(p, lds, bx, G, wave, lane); convout_items(p, bx * (NWAVES * 64) + tid, G * NWAVES * 64); SEAM(PH_MG); } \
    if (IN(PH_MM)) { for (int u = bx; u < NSEG * 8; u += G) pm_unit(p, lds, u, tid, wave, lane); SEAM(PH_MM); } \
    if (IN(PH_MS)) { ps_scan(p, bx * (NWAVES * 64) + tid, G * NWAVES * 64); s5_scan(p, bx * (NWAVES * 64) + tid, G * NWAVES * 64); SEAM(PH_MS); } \
    if (IN(PH_MO)) { for (int u = bx; u < (MR / 64) * 4; u += G) po_unit(p, lds, u, tid, wave, lane); \
                     s5_phase<true>(p, lds, bx, G, wave, lane); SEAM(PH_MO); }
#define HOST_PROGRAM \
    launch_phases(p, PH_PRO, PH_N, 0, stream);
#ifndef PG8_SP2
#define PG8_SP2 true
#endif
#ifndef PG8_ALIGN
#define PG8_ALIGN true
#endif
enum { PH_PRO = 0, PH_G1 = 1, PH_D1 = 2, PH_WIN = 3, PH_MG = 4, PH_MM = 5, PH_MS = 6, PH_MO = 7, PH_GLU = 8, PH_WOUT = 9, PH_G2 = 10, PH_D2 = 11, PH_FIN = 12, PH_N = 13 };
struct Args { Prm p; int ph_lo, ph_hi, li, pad; };
__global__ void __launch_bounds__(NWAVES * 64, 2) mk_fwd(Args a) {
    extern __shared__ __attribute__((aligned(16))) unsigned char lds_raw[];
    LAS unsigned char* lds = (LAS unsigned char*)lds_raw;
    volatile LAS unsigned* MISC = (volatile LAS unsigned*)(lds + MISC_OFF);
    const int tid = threadIdx.x, lane = tid & 63, wave = __builtin_amdgcn_readfirstlane(tid >> 6);
    const int G = gridDim.x; const int bx = blockIdx.x; const int vcu = (G % 8 == 0) ? (bx % 8) * (G / 8) + bx / 8 : bx;
    const Prm& p = a.p; unsigned char* ws = p.ws;
    gu32* ctl = (gu32*)(ws + WS_CTL);
    for (int u = tid; u < (LDS_BYTES - LDSCTL_OFF) / 4; u += NWAVES * 64) ((LAS unsigned*)(lds + LDSCTL_OFF))[u] = 0u;
    __syncthreads();
    const int lo = a.ph_lo, hi = a.ph_hi;
    const bool use_bar = (hi - lo) > 1;
    XcdBarrier bar; bar.bar = (unsigned*)(ctl + CW_BAR) + a.li * XCD_BAR_WORDS; bar.x = 0; bar.st = nullptr;
    if (use_bar) bar = xcd_barrier_post((unsigned*)(ctl + CW_BAR) + a.li * XCD_BAR_WORDS, MISC + 8);
#define IN(k) (lo <= (k) && (k) < hi)
#define SEAM(k) do { if (IN(k) && IN((k) + 1)) xcd_barrier(bar); } while (0)
    bf16* XB = (bf16*)(ws + WS_XB); bf16* HB = (bf16*)(ws + WS_H); bf16* UB = (bf16*)(ws + WS_U); bf16* XMB = (bf16*)(ws + WS_XM); bf16* ZB = (bf16*)(ws + WS_Z);
    float* SQ0 = (float*)(ws + WS_SQ0); float* SQ1 = (float*)(ws + WS_SQ1); float* SQ2 = (float*)(ws + WS_SQ2); float* SQ3 = (float*)(ws + WS_SQ3); float* SQ5 = (float*)(ws + WS_SQ5); float* SQM = (float*)(ws + WS_SQM);
    constexpr int NOSPLIT = 1 << 30;

    if (IN(PH_PRO)) { p0_prologue(p, lds, vcu, G, wave, lane); SEAM(PH_PRO); }
    if (IN(PH_G1)) {
        pg8::Gemm g{XB, (const bf16*)(ws + WS_W1GU), MR, 2 * FF, D, D, NOSPLIT, 0}; pg8::StaticOrder S; S.init(MR, 2 * FF, G, bx);
        pg8::EpiSwigluF E{SQ0, HB};
        pg8::gemm_phase<pg8::EpiSwigluF, pg8::StaticOrder, PG8_ALIGN, PG8_SP2>(lds + RING_OFF, g, S, E);
        SEAM(PH_G1);
    }
    if (IN(PH_D1)) {
        pg8::Gemm g{HB, (const bf16*)(ws + WS_W1D), MR, D, FF, FF, NOSPLIT, 0}; pg8::StaticOrder S; S.init(MR, D, G, bx);
        pg8::EpiResidF<true, false> E{p, 0.5f, nullptr, nullptr, SQ1, XB};
        pg8::gemm_phase<pg8::EpiResidF<true, false>, pg8::StaticOrder, PG8_ALIGN, PG8_SP2>(lds + RING_OFF, g, S, E);
        SEAM(PH_D1);
    }
    if (IN(PH_WIN)) {
        pg8::Gemm g{XB, (const bf16*)(ws + WS_WIN), MR, NPROJ, D, D, NOSPLIT, 0}; pg8::StaticOrder S; S.init(MR, NPROJ, G, bx);
        pg8::EpiWinF E{SQ1, UB};
        pg8::gemm_phase<pg8::EpiWinF, pg8::StaticOrder, PG8_ALIGN, PG8_SP2>(lds + RING_OFF, g, S, E);
        SEAM(PH_WIN);
    }
    MIXER_PHASES
    if (IN(PH_GLU)) {
        pg8::Gemm g{UB, (const bf16*)(ws + WS_WGLU), MR, D, D, D, NOSPLIT, 0}; pg8::StaticOrder S; S.init(MR, D, G, bx);
        pg8::EpiGluF E{UB, p.in[I_GLUB], XMB, SQ5};
        pg8::gemm_phase<pg8::EpiGluF, pg8::StaticOrder, PG8_ALIGN, PG8_SP2>(lds + RING_OFF, g, S, E);
        SEAM(PH_GLU);
    }
    if (IN(PH_WOUT)) {
        pg8::Gemm g{XMB, (const bf16*)(ws + WS_WOUT), MR, D, 2 * D, D, 16, (ptrdiff_t)WS_Z - (ptrdiff_t)WS_XM - 16 * 128}; pg8::StaticOrder S; S.init(MR, D, G, bx);
        pg8::EpiResidF<false, true> E{p, 1.0f, SQM, SQ5, SQ2, XB};
        pg8::gemm_phase<pg8::EpiResidF<false, true>, pg8::StaticOrder, PG8_ALIGN, PG8_SP2>(lds + RING_OFF, g, S, E);
        SEAM(PH_WOUT);
    }
    if (IN(PH_G2)) {
        pg8::Gemm g{XB, (const bf16*)(ws + WS_W2GU), MR, 2 * FF, D, D, NOSPLIT, 0}; pg8::StaticOrder S; S.init(MR, 2 * FF, G, bx);
        pg8::EpiSwigluF E{SQ2, HB};
        pg8::gemm_phase<pg8::EpiSwigluF, pg8::StaticOrder, PG8_ALIGN, PG8_SP2>(lds + RING_OFF, g, S, E);
        SEAM(PH_G2);
    }
    if (IN(PH_D2)) {
        pg8::Gemm g{HB, (const bf16*)(ws + WS_W2D), MR, D, FF, FF, NOSPLIT, 0}; pg8::StaticOrder S; S.init(MR, D, G, bx);
        pg8::EpiResidF<false, false> E{p, 0.5f, nullptr, nullptr, SQ3, nullptr};
        pg8::gemm_phase<pg8::EpiResidF<false, false>, pg8::StaticOrder, PG8_ALIGN, PG8_SP2>(lds + RING_OFF, g, S, E);
        SEAM(PH_D2);
    }
    if (IN(PH_FIN)) p_final(p, vcu, G, wave, lane);
#undef IN
#undef SEAM
}
static int g_grid = 0;
static void launch_phases(const Prm& p, int lo, int hi, int li, hipStream_t stream) {
    Args a{}; a.p = p; a.ph_lo = lo; a.ph_hi = hi; a.li = li; a.pad = 0;
    hipLaunchKernelGGL(mk_fwd, dim3(g_grid), dim3(NWAVES * 64), LDS_BYTES, stream, a);
}
extern "C" void kernel_launch(void* const* d_in, const int* in_sizes, int n_in, void* d_out, int out_size, void* d_ws, size_t ws_size, hipStream_t stream) {
    if (g_grid == 0) {
        if (n_in != N_IN || out_size != (int)O_END || ws_size < WS_END) { fprintf(stderr, "kernel_launch: unexpected sizes n_in %d out %d ws %zu\n", n_in, out_size, ws_size); g_grid = -1; return; }
        int dev = 0, cus = 0;
        if (hipGetDevice(&dev) != hipSuccess || hipDeviceGetAttribute(&cus, hipDeviceAttributeMultiprocessorCount, dev) != hipSuccess) { g_grid = -1; return; }
        if (hipFuncSetAttribute((const void*)mk_fwd, hipFuncAttributeMaxDynamicSharedMemorySize, LDS_BYTES) != hipSuccess) { fprintf(stderr, "kernel_launch: hipFuncSetAttribute failed\n"); g_grid = -1; return; }
        g_grid = cus;
    }
    if (g_grid < 0) return;
    Prm p{}; for (int i = 0; i < N_IN; ++i) p.in[i] = (const float*)d_in[i]; p.out = (float*)d_out; p.ws = (unsigned char*)d_ws;
    (void)hipMemsetAsync(p.ws + WS_CTL, 0, CTL_ZERO_BYTES, stream);
    HOST_PROGRAM
}
```
